# Optimizing an MI355X kernel written in HIP

```python
import jax, jax.numpy as jnp
from jax import lax
import numpy as np

D_MODEL = 2048
BATCH = 4
SEQ = 4096
DEPTH = 1

CHUNK = 64
Q_BLOCK = 128
ROPE_THETA = 500000.0
EPS = 1e-5

A_HEADS = 8
A_HEAD_DIM = 128
A_ROT_DIM = A_HEAD_DIM // 4
IDX_HEADS = 16
IDX_DIM = 64
IDX_ROT_DIM = IDX_DIM // 4
TOPK_MAX = 256
INDEX_SCALE = (IDX_DIM ** -0.5) * (IDX_HEADS ** -0.5)

B_HEADS = 8
Q_LORA = 512
KV_LORA = 256
QK_NOPE = 128
QK_ROPE = 64
V_HEAD = 128

A_WIDTH = A_HEADS * A_HEAD_DIM
B_WIDTH = B_HEADS * V_HEAD
MIX_WIDTH = A_WIDTH + B_WIDTH

IN_SPLITS = (A_WIDTH, A_WIDTH, A_WIDTH,
             IDX_HEADS * IDX_DIM, IDX_DIM, IDX_HEADS,
             Q_LORA, KV_LORA, QK_ROPE)
IN_WIDTH = sum(IN_SPLITS)

N_EXPERTS = 32
TOP_K_EXPERTS = 4
D_FF = D_MODEL
SWIGLU_LIMIT = 7.0
SWIGLU_ALPHA = 1.702
MOE_BLOCK = 128

ALPHA = (2 * DEPTH) ** 0.25
BETA = (8 * DEPTH) ** -0.25

kernel_name = "hybrid_dsa_mla_moe_deepnorm_adaln"


def layer_norm_plain(x):
    xf = x.astype(jnp.float32)
    mu = jnp.mean(xf, -1, keepdims=True)
    var = jnp.mean(jnp.square(xf - mu), -1, keepdims=True)
    return ((xf - mu) * lax.rsqrt(var + EPS)).astype(x.dtype)


def layer_norm(x, g, b):
    return (layer_norm_plain(x) * g + b).astype(x.dtype)


def rms_norm(x, g):
    xf = x.astype(jnp.float32)
    y = xf * lax.rsqrt(jnp.mean(jnp.square(xf), -1, keepdims=True) + EPS)
    return (y * g).astype(x.dtype)


def apply_rope(x, positions, rot_dim):
    half = rot_dim // 2
    inv_freq = ROPE_THETA ** (-jnp.arange(half, dtype=jnp.float32) / half)
    ang = positions.astype(jnp.float32)[..., None] * inv_freq
    cos = jnp.cos(ang)[:, :, None, :]
    sin = jnp.sin(ang)[:, :, None, :]
    xr = x[..., :rot_dim].astype(jnp.float32)
    x1, x2 = xr[..., :half], xr[..., half:]
    rot = jnp.concatenate([x1 * cos - x2 * sin, x2 * cos + x1 * sin], -1).astype(x.dtype)
    return jnp.concatenate([rot, x[..., rot_dim:]], -1)


def dsa_attention(q, k, v, iq, ik, iw):
    B, S, H, dh = q.shape
    n_chunks = S // CHUNK
    topk = min(TOPK_MAX, S // 4)
    key_chunk = jnp.arange(S) // CHUNK
    gather = jax.vmap(lambda t, i: t[i])

    def to_chunks(t):
        return jnp.moveaxis(t.reshape((B, n_chunks, CHUNK) + t.shape[2:]), 1, 0)

    def one_chunk(args):
        qc, iqc, iwc, ci = args
        rel = jax.nn.relu(jnp.einsum("bqhd,bsd->bqhs", iqc, ik,
                                     preferred_element_type=jnp.float32))
        index_score = jnp.einsum("bqhs,bqh->bqs", rel, iwc.astype(jnp.float32)) * INDEX_SCALE
        visible = key_chunk <= ci
        index_score = jnp.where(visible[None, None, :], index_score, -jnp.inf)
        _, sel = lax.top_k(index_score, topk)
        k_sel = gather(k, sel)
        v_sel = gather(v, sel)
        s = jnp.einsum("bqhd,bqkhd->bhqk", qc, k_sel,
                       preferred_element_type=jnp.float32) * (dh ** -0.5)
        ok = (sel // CHUNK) <= ci
        s = jnp.where(ok[:, None], s, -jnp.inf)
        p = jax.nn.softmax(s, axis=-1).astype(v.dtype)
        return jnp.einsum("bhqk,bqkhd->bqhd", p, v_sel)

    out = lax.map(one_chunk, (to_chunks(q), to_chunks(iq), to_chunks(iw),
                              jnp.arange(n_chunks)))
    return jnp.moveaxis(out, 0, 1).reshape(B, S, H, dh)


def block_causal_attention(q, k, v):
    B, S, H, dq = q.shape
    n_blocks = S // Q_BLOCK
    key_chunk = jnp.arange(S) // CHUNK
    qs = jnp.moveaxis(q.reshape(B, n_blocks, Q_BLOCK, H, dq), 1, 0)

    def one_block(args):
        qb, bi = args
        q_chunk = (bi * Q_BLOCK + jnp.arange(Q_BLOCK)) // CHUNK
        s = jnp.einsum("bqhd,bshd->bhqs", qb, k,
                       preferred_element_type=jnp.float32) * (dq ** -0.5)
        mask = key_chunk[None, :] <= q_chunk[:, None]
        s = jnp.where(mask, s, -jnp.inf)
        p = jax.nn.softmax(s, axis=-1).astype(v.dtype)
        return jnp.einsum("bhqs,bshd->bqhd", p, v)

    out = lax.map(one_block, (qs, jnp.arange(n_blocks)))
    return jnp.moveaxis(out, 0, 1).reshape(B, S, H, v.shape[-1])


def token_mixers(h, positions, w_in, idx_k_norm_g, idx_k_norm_b, q_norm_g, w_q_up,
                 kv_norm_g, w_kv_up, out_norm_a_g, out_norm_b_g, w_out):
    B, S, _ = h.shape
    proj = h @ w_in
    offsets = np.cumsum(IN_SPLITS)[:-1].tolist()
    aq, ak, av, iq, ik, iw, qd, kvd, kr = jnp.split(proj, offsets, axis=-1)

    aq = apply_rope(aq.reshape(B, S, A_HEADS, A_HEAD_DIM), positions, A_ROT_DIM)
    ak = apply_rope(ak.reshape(B, S, A_HEADS, A_HEAD_DIM), positions, A_ROT_DIM)
    av = av.reshape(B, S, A_HEADS, A_HEAD_DIM)
    iq = apply_rope(iq.reshape(B, S, IDX_HEADS, IDX_DIM), positions, IDX_ROT_DIM)
    ik = layer_norm(ik, idx_k_norm_g, idx_k_norm_b)
    ik = apply_rope(ik[:, :, None, :], positions, IDX_ROT_DIM)[:, :, 0, :]
    out_a = dsa_attention(aq, ak, av, iq, ik, iw).reshape(B, S, A_WIDTH)

    cq = rms_norm(qd, q_norm_g)
    qb = (cq @ w_q_up).reshape(B, S, B_HEADS, QK_NOPE + QK_ROPE)
    q_rope = apply_rope(qb[..., QK_NOPE:], positions, QK_ROPE)
    qb = jnp.concatenate([qb[..., :QK_NOPE], q_rope], -1)
    ckv = rms_norm(kvd, kv_norm_g)
    kv = (ckv @ w_kv_up).reshape(B, S, B_HEADS, QK_NOPE + V_HEAD)
    k_rope = apply_rope(kr[:, :, None, :], positions, QK_ROPE)
    kb = jnp.concatenate([kv[..., :QK_NOPE],
                          jnp.broadcast_to(k_rope, (B, S, B_HEADS, QK_ROPE))], -1)
    vb = kv[..., QK_NOPE:]
    out_b = block_causal_attention(qb, kb, vb).reshape(B, S, B_WIDTH)

    merged = jnp.concatenate([rms_norm(out_a, out_norm_a_g),
                              rms_norm(out_b, out_norm_b_g)], -1)
    return merged @ w_out


def moe_ffn(h, w_router, b_router, w_gate_up, b_gate_up, w_down, b_down):
    B, S, D = h.shape
    N = B * S
    xt = h.reshape(N, D)
    logits = (xt @ w_router + b_router).astype(jnp.float32)
    top_logit, top_e = lax.top_k(logits, TOP_K_EXPERTS)
    gates = jax.nn.softmax(top_logit, axis=-1)

    A = N * TOP_K_EXPERTS
    e_flat = top_e.reshape(A)
    tok_flat = jnp.repeat(jnp.arange(N, dtype=jnp.int32), TOP_K_EXPERTS)
    g_flat = gates.reshape(A)
    order = jnp.argsort(e_flat)
    e_sorted, tok_sorted, g_sorted = e_flat[order], tok_flat[order], g_flat[order]

    counts = jnp.zeros((N_EXPERTS,), jnp.int32).at[e_flat].add(1)
    starts = jnp.cumsum(counts) - counts
    padded = (counts + MOE_BLOCK - 1) // MOE_BLOCK * MOE_BLOCK
    pad_ends = jnp.cumsum(padded)
    pad_starts = pad_ends - padded
    dest = pad_starts[e_sorted] + (jnp.arange(A, dtype=jnp.int32) - starts[e_sorted])

    n_blocks = (A + MOE_BLOCK - 1) // MOE_BLOCK + N_EXPERTS
    R = n_blocks * MOE_BLOCK
    row_tok = jnp.full((R,), N, jnp.int32).at[dest].set(tok_sorted)
    row_gate = jnp.zeros((R,), jnp.float32).at[dest].set(g_sorted)
    block_e = jnp.minimum(
        jnp.searchsorted(pad_ends, jnp.arange(n_blocks, dtype=jnp.int32) * MOE_BLOCK,
                         side="right"), N_EXPERTS - 1)
    x_pad = jnp.concatenate([xt, jnp.zeros((1, D), xt.dtype)], 0)

    def one_block(args):
        toks, gts, e = args
        xb = x_pad[toks]
        gu = xb @ w_gate_up[e] + b_gate_up[e]
        g, u = gu[:, ::2], gu[:, 1::2]
        g = jnp.minimum(g, SWIGLU_LIMIT)
        u = jnp.clip(u, -SWIGLU_LIMIT, SWIGLU_LIMIT)
        act = (u + 1.0) * (g * jax.nn.sigmoid(SWIGLU_ALPHA * g))
        y = act @ w_down[e] + b_down[e]
        return y * gts[:, None].astype(y.dtype)

    ys = lax.map(one_block, (row_tok.reshape(n_blocks, MOE_BLOCK),
                             row_gate.reshape(n_blocks, MOE_BLOCK), block_e))
    out = jnp.zeros((N + 1, D), h.dtype).at[row_tok].add(ys.reshape(R, D))
    return out[:N].reshape(B, S, D)


def setup_inputs(seed: int = 0) -> dict:
    key = jax.random.key(seed)
    ks = jax.random.split(key, 25)
    f32 = jnp.float32

    def nrm(k, shape, fan_in, scale=1.0):
        return jax.random.normal(k, shape, f32) * (scale * fan_in ** -0.5)

    def gain(k, shape):
        return 1.0 + 0.01 * jax.random.normal(k, shape, f32)

    def bias(k, shape):
        return 0.01 * jax.random.normal(k, shape, f32)

    L = DEPTH
    return {
        "x": jax.random.normal(ks[0], (BATCH, SEQ, D_MODEL), f32),
        "c": jax.random.normal(ks[1], (BATCH, D_MODEL), f32),
        "positions": jnp.arange(SEQ, dtype=jnp.int32)[None, :]
                     + jax.random.randint(ks[2], (BATCH, 1), 0, 8192, jnp.int32),
        "w_ada": nrm(ks[3], (L, D_MODEL, 6 * D_MODEL), D_MODEL, 0.5),
        "b_ada": bias(ks[4], (L, 6 * D_MODEL)),
        "w_in": nrm(ks[5], (L, D_MODEL, IN_WIDTH), D_MODEL),
        "idx_k_norm_g": gain(ks[6], (L, IDX_DIM)),
        "idx_k_norm_b": bias(ks[7], (L, IDX_DIM)),
        "q_norm_g": gain(ks[8], (L, Q_LORA)),
        "w_q_up": nrm(ks[9], (L, Q_LORA, B_HEADS * (QK_NOPE + QK_ROPE)), Q_LORA),
        "kv_norm_g": gain(ks[10], (L, KV_LORA)),
        "w_kv_up": nrm(ks[11], (L, KV_LORA, B_HEADS * (QK_NOPE + V_HEAD)), KV_LORA),
        "out_norm_a_g": gain(ks[12], (L, A_WIDTH)),
        "out_norm_b_g": gain(ks[13], (L, B_WIDTH)),
        "w_out": nrm(ks[14], (L, MIX_WIDTH, D_MODEL), MIX_WIDTH, BETA),
        "ln_mix_g": gain(ks[15], (L, D_MODEL)),
        "ln_mix_b": bias(ks[16], (L, D_MODEL)),
        "w_router": nrm(ks[17], (L, D_MODEL, N_EXPERTS), D_MODEL),
        "b_router": bias(ks[18], (L, N_EXPERTS)),
        "w_gate_up": nrm(ks[19], (L, N_EXPERTS, D_MODEL, 2 * D_FF), D_MODEL),
        "b_gate_up": bias(ks[20], (L, N_EXPERTS, 2 * D_FF)),
        "w_down": nrm(ks[21], (L, N_EXPERTS, D_FF, D_MODEL), D_FF, BETA),
        "b_down": bias(ks[22], (L, N_EXPERTS, D_MODEL)),
        "ln_ffn_g": gain(ks[23], (L, D_MODEL)),
        "ln_ffn_b": bias(ks[24], (L, D_MODEL)),
    }


def reference(x, c, positions, w_ada, b_ada, w_in, idx_k_norm_g, idx_k_norm_b,
              q_norm_g, w_q_up, kv_norm_g, w_kv_up, out_norm_a_g, out_norm_b_g, w_out,
              ln_mix_g, ln_mix_b, w_router, b_router, w_gate_up, b_gate_up, w_down,
              b_down, ln_ffn_g, ln_ffn_b):
    for l in range(DEPTH):
        ada = jax.nn.silu(c) @ w_ada[l] + b_ada[l]
        sh1, sc1, g1, sh2, sc2, g2 = jnp.split(ada[:, None, :], 6, axis=-1)

        h = layer_norm_plain(x) * (1.0 + sc1) + sh1
        mix = token_mixers(h, positions, w_in[l], idx_k_norm_g[l], idx_k_norm_b[l],
                           q_norm_g[l], w_q_up[l], kv_norm_g[l], w_kv_up[l],
                           out_norm_a_g[l], out_norm_b_g[l], w_out[l])
        x = layer_norm(ALPHA * x + g1 * mix, ln_mix_g[l], ln_mix_b[l])

        h = layer_norm_plain(x) * (1.0 + sc2) + sh2
        ffn = moe_ffn(h, w_router[l], b_router[l], w_gate_up[l], b_gate_up[l],
                      w_down[l], b_down[l])
        x = layer_norm(ALPHA * x + g2 * ffn, ln_ffn_g[l], ln_ffn_b[l])
    return x
```

```cpp
#include <hip/hip_runtime.h>
#include <stdint.h>
#include <stdio.h>

#define DEVINL __device__ __forceinline__
#ifndef REPEAT_P
#define REPEAT_P 0
#endif
#ifndef P2_WGM
#define P2_WGM 4
#endif
#ifndef HEAD_STEPS
#define HEAD_STEPS 21
#endif
#ifndef CONV_C
#define CONV_C 96
#endif
#ifndef PROBE_ATT
#define PROBE_ATT 0
#endif
#ifndef PROBE_IDX
#define PROBE_IDX 0
#endif
#ifndef OUTPROJ_F8
#define OUTPROJ_F8 1
#endif
#ifndef EXTRA_BARRIERS
#define EXTRA_BARRIERS 0
#endif
#ifndef DUMMY_READ
#define DUMMY_READ 0
#endif
#ifndef DUMMY_GEMM
#define DUMMY_GEMM 0
#endif
#define REPS(k) (((REPEAT_P >> (k)) & 1) ? 2 : 1)
#ifndef MULTI_LAUNCH
#define MULTI_LAUNCH 0
#endif
#ifndef MOE_FAST
#define MOE_FAST 1
#endif
typedef float f32x4 __attribute__((ext_vector_type(4)));
typedef float f32x2 __attribute__((ext_vector_type(2)));
typedef float f32x16 __attribute__((ext_vector_type(16)));
typedef unsigned long long u64;
typedef _Float16 f16;
typedef _Float16 f16x8 __attribute__((ext_vector_type(8)));
typedef _Float16 f16x2 __attribute__((ext_vector_type(2)));
typedef unsigned u32x4 __attribute__((ext_vector_type(4)));
typedef unsigned u32x2 __attribute__((ext_vector_type(2)));
#define LAS __attribute__((address_space(3)))

constexpr int D = 2048, NB = 4, S = 4096, NT = NB * S, INW = 5008;
constexpr int O_AQ = 0, O_AK = 1024, O_AV = 2048, O_IQ = 3072, O_IK = 4096, O_IW = 4160, O_QD = 4176, O_KVD = 4688, O_KR = 4944;
constexpr int NE = 32, DFF = 2048, LISTCAP = NT;
constexpr float EPS = 1e-5f, ALPHA = 1.18920711500272106672f, INDEX_SCALE = 0.03125f;
constexpr float THETA = 500000.0f;
constexpr int NWAVES = 8, NTHREADS = 512;
constexpr int LDS_BYTES = 147456;

constexpr size_t MiB = 1u << 20;
constexpr size_t WS_CTL = 0, CTL_ZERO_BYTES = 1 * MiB;
constexpr size_t WS_ADA = 1 * MiB, WS_LIST = 2 * MiB, WS_TOPE = 4 * MiB, WS_GATE = 5 * MiB, WS_MASK = 8 * MiB;
constexpr size_t WS_H = 16 * MiB, WS_PROJ = 144 * MiB, WS_QB = 460 * MiB, WS_KV = 556 * MiB, WS_OAB = 684 * MiB, WS_X1 = 812 * MiB;
constexpr size_t WS_ACT = 940 * MiB, WS_Y = 1452 * MiB, WS_END = 1964 * MiB;
constexpr int CW_CNT = 16384, CW_BAR = 4096;
constexpr size_t WS_WINT = 1964 * MiB, WS_HA = 1984 * MiB, WS_PROJH = 2048 * MiB, WS_TAB = 2208 * MiB, WS_SSQ = 2216 * MiB, WS_SSKV = 2217 * MiB, WS_END2 = 2218 * MiB;
constexpr size_t WS_WOUTT = 2220 * MiB, WS_WGUT = 2228 * MiB, WS_WDT = 2740 * MiB, WS_BGUP = 2996 * MiB, WS_MRGH = 2998 * MiB, WS_ACT16 = 3062 * MiB, WS_Y16 = 3350 * MiB, WS_END3 = 3606 * MiB;
constexpr size_t WS_IKV = 3790 * MiB;
constexpr size_t WS_WRT = 3789 * MiB;
constexpr size_t WS_SCORE = 16 * MiB;
constexpr size_t WS_RQ = 3786 * MiB, WS_RKV = 3787 * MiB;
constexpr size_t WS_WQUPT = 3606 * MiB, WS_WKVUPT = 3608 * MiB, WS_QB16 = 3610 * MiB, WS_KV16 = 3658 * MiB, WS_ATT16 = 3722 * MiB, WS_END4 = 3791 * MiB;
constexpr int NV = 5120;
constexpr int V_AQ = 0, V_AK = 1024, V_AV = 2048, V_IQ = 3072, V_QD = 4096, V_KVD = 4608, V_IK_LO = 4864, V_IW = 4896, V_KR = 4928, V_IK_HI = 4992;
constexpr int TABW = 112, T_CA = 0, T_SA = 16, T_CI = 32, T_SI = 40, T_CR = 48, T_SR = 80;

struct Args { const void* in[25]; float* out; unsigned char* ws; int ph_lo, ph_hi; };

struct Frame {
    int tid, lane, wave, G, bid;
    const float *x, *c, *w_ada, *b_ada, *w_in, *ikg, *ikb, *qng, *w_q_up, *kvng, *w_kv_up, *onag, *onbg, *w_out, *lnmg, *lnmb, *w_router, *b_router, *w_gu, *b_gu, *w_dn, *b_dn, *lnfg, *lnfb;
    const int* pos;
    float* out;
    unsigned* ctl; float* ada; int* list; int* tope; float* gate; u64* mask;
    float *h, *proj, *qb, *kv, *oab, *x1, *act, *y;
    f16 *WinT, *hA, *projh; float *tab, *ssq, *sskv;
    f16 *WoutT, *WguT, *WdT, *mrgh, *act16, *y16; float* bguP;
    f16 *WqupT, *WkvupT, *qb16, *kv16, *att16; float *rq, *rkv, *score; f16* WrT; float* ikv;
};

DEVINL float wave_sum(float v) {
#define WS_DPP(ctrl_, rm_) v += __builtin_bit_cast(float, __builtin_amdgcn_update_dpp(0, __builtin_bit_cast(int, v), ctrl_, rm_, 0xf, false))
    WS_DPP(0x111, 0xf); WS_DPP(0x112, 0xf); WS_DPP(0x114, 0xf); WS_DPP(0x118, 0xf); WS_DPP(0x142, 0xa); WS_DPP(0x143, 0xc);
#undef WS_DPP
    return __builtin_bit_cast(float, __builtin_amdgcn_readlane(__builtin_bit_cast(int, v), 63));
}
typedef _Float16 f16x4 __attribute__((ext_vector_type(4)));
DEVINL f32x4 ld4h(const f16* p) { const f16x4 h = *(const f16x4*)p; return __builtin_convertvector(h, f32x4); }
DEVINL unsigned pk_f16(float lo, float hi) { const f16x2 h = {(f16)lo, (f16)hi}; return __builtin_bit_cast(unsigned, h); }
DEVINL void rope_cs(float pos, int i, int half, float& c, float& s) {
    const float inv = powf(THETA, -(float)i / (float)half);
    const float ang = pos * inv;
    sincosf(ang, &s, &c);
}

template <class RowPtr, class Epi>
DEVINL void gemm_tile_f32(float* lds, const RowPtr& rowptr, const float* __restrict__ Bm, int ldb, int Kd, int n0, int N, const Epi& epi) {
    float* As = lds;
    float* Bs = lds + 32 * 129;
    int tid_ = threadIdx.x; asm volatile("" : "+v"(tid_));
    const int tid = tid_, lane = tid & 63, wid = tid >> 6, wm = wid >> 2, wn = wid & 3;
    const int arow = tid >> 2, akq = tid & 3;
    const float* ap = rowptr(arow) + akq * 8;
    const int bk = tid >> 4, bn = (tid & 15) * 16;
    const float* bp = Bm + (size_t)bk * ldb + n0 + bn;
    f32x16 acc[2][2];
#pragma unroll
    for (int i = 0; i < 2; ++i)
#pragma unroll
        for (int j = 0; j < 2; ++j)
#pragma unroll
            for (int r = 0; r < 16; ++r) acc[i][j][r] = 0.f;
    f32x4 ra[2], rb[4];
    const f32x4 z4 = {0.f, 0.f, 0.f, 0.f};
    ra[0] = *(const f32x4*)(ap); ra[1] = *(const f32x4*)(ap + 4);
#pragma unroll
    for (int i = 0; i < 4; ++i) rb[i] = (n0 + bn + 4 * i < N) ? *(const f32x4*)(bp + 4 * i) : z4;
    for (int k0 = 0; k0 < Kd; k0 += 32) {
        __syncthreads();
#pragma unroll
        for (int j = 0; j < 8; ++j) As[(akq * 8 + j) * 129 + arow] = ra[j >> 2][j & 3];
#pragma unroll
        for (int i = 0; i < 4; ++i) *(f32x4*)(Bs + bk * 256 + bn + 4 * i) = rb[i];
        __syncthreads();
        if (k0 + 32 < Kd) {
            ra[0] = *(const f32x4*)(ap + k0 + 32); ra[1] = *(const f32x4*)(ap + k0 + 36);
#pragma unroll
            for (int i = 0; i < 4; ++i) rb[i] = (n0 + bn + 4 * i < N) ? *(const f32x4*)(bp + (size_t)(k0 + 32) * ldb + 4 * i) : z4;
        }
#pragma unroll
        for (int kk = 0; kk < 32; kk += 2) {
            const int kr = kk + (lane >> 5);
            const float a0 = As[kr * 129 + wm * 64 + (lane & 31)], a1 = As[kr * 129 + wm * 64 + 32 + (lane & 31)];
            const float b0 = Bs[kr * 256 + wn * 64 + (lane & 31)], b1 = Bs[kr * 256 + wn * 64 + 32 + (lane & 31)];
            acc[0][0] = __builtin_amdgcn_mfma_f32_32x32x2f32(a0, b0, acc[0][0], 0, 0, 0);
            acc[0][1] = __builtin_amdgcn_mfma_f32_32x32x2f32(a0, b1, acc[0][1], 0, 0, 0);
            acc[1][0] = __builtin_amdgcn_mfma_f32_32x32x2f32(a1, b0, acc[1][0], 0, 0, 0);
            acc[1][1] = __builtin_amdgcn_mfma_f32_32x32x2f32(a1, b1, acc[1][1], 0, 0, 0);
        }
    }
#pragma unroll
    for (int i = 0; i < 2; ++i)
#pragma unroll
        for (int j = 0; j < 2; ++j)
#pragma unroll
            for (int r = 0; r < 16; ++r) {
                const int row = wm * 64 + i * 32 + (r & 3) + 8 * (r >> 2) + 4 * (lane >> 5);
                const int col = n0 + wn * 64 + j * 32 + (lane & 31);
                epi(row, col, acc[i][j][r]);
            }
    __syncthreads();
}

struct RowLin { const float* base; size_t ld; int m0; DEVINL const float* operator()(int r) const { return base + (size_t)(m0 + r) * ld; } };

DEVINL void p_ada(Frame& F, float* lds) {
    float* sc = lds;
    float* red = lds + 4 * D;
    for (int i = F.tid; i < 4 * D; i += NTHREADS) { const float v = F.c[i]; sc[i] = v / (1.f + expf(-v)); }
    __syncthreads();
    const int cg = F.tid & 15, kp = F.tid >> 4;
    for (int u = F.bid; u < 6 * D / 64; u += F.G) {
        const float* wp = F.w_ada + (size_t)kp * (6 * D) + u * 64 + 4 * cg;
        f32x4 a0 = {0.f, 0.f, 0.f, 0.f}, a1 = a0, a2 = a0, a3 = a0;
#pragma unroll 8
        for (int i = 0; i < 64; ++i) {
            const int k = kp + 32 * i;
            const f32x4 w = *(const f32x4*)(wp + (size_t)(32 * i) * (6 * D));
            a0 += w * sc[k]; a1 += w * sc[D + k]; a2 += w * sc[2 * D + k]; a3 += w * sc[3 * D + k];
        }
        float* rp = red + (kp * 16 + cg) * 16;
        *(f32x4*)(rp) = a0; *(f32x4*)(rp + 4) = a1; *(f32x4*)(rp + 8) = a2; *(f32x4*)(rp + 12) = a3;
        __syncthreads();
        if (F.tid < 256) {
            const int b = F.tid >> 6, c = F.tid & 63; float s2 = 0.f;
            for (int p = 0; p < 32; ++p) s2 += red[(p * 16 + (c >> 2)) * 16 + b * 4 + (c & 3)];
            F.ada[b * 6 * D + u * 64 + c] = s2 + F.b_ada[u * 64 + c];
        }
        __syncthreads();
    }
}

DEVINL void p_lnmod(Frame& F) {
    const int gw = F.bid * NWAVES + F.wave, NGW = F.G * NWAVES;
    for (int m = gw; m < NT; m += NGW) {
        const int b = m / S;
        const f32x4* xr = (const f32x4*)(F.x + (size_t)m * D) + F.lane;
        f32x4 v[8]; float s = 0.f;
#pragma unroll
        for (int j = 0; j < 8; ++j) { v[j] = xr[64 * j]; s += (v[j].x + v[j].y) + (v[j].z + v[j].w); }
        const float mean = wave_sum(s) * (1.f / D); float s2 = 0.f;
#pragma unroll
        for (int j = 0; j < 8; ++j) { v[j] = v[j] - mean; s2 += (v[j].x * v[j].x + v[j].y * v[j].y) + (v[j].z * v[j].z + v[j].w * v[j].w); }
        const float rstd = 1.f / sqrtf(wave_sum(s2) * (1.f / D) + EPS);
        const f32x4* sh = (const f32x4*)(F.ada + (size_t)b * 6 * D) + F.lane;
        const f32x4* scp = (const f32x4*)(F.ada + (size_t)b * 6 * D + D) + F.lane;
        f32x4* o = (f32x4*)(F.h + (size_t)m * D) + F.lane;
#pragma unroll
        for (int j = 0; j < 8; ++j) o[64 * j] = v[j] * rstd * (scp[64 * j] + 1.f) + sh[64 * j];
    }
}

DEVINL void p_post(Frame& F) {
    const int gw = F.bid * NWAVES + F.wave, NGW = F.G * NWAVES, lane = F.lane;
    for (int m = gw; m < NT; m += NGW) {
        float* p = F.proj + (size_t)m * INW;
        const float pos = (float)F.pos[m];
#pragma unroll
        for (int j = 0; j < 4; ++j) {
            const int id = lane + 64 * j, which = id >> 7, hd = (id >> 4) & 7, i = id & 15;
            float* q = p + (which ? O_AK : O_AQ) + hd * 128;
            float c, s; rope_cs(pos, i, 16, c, s);
            const float x1 = q[i], x2 = q[i + 16];
            q[i] = x1 * c - x2 * s; q[i + 16] = x2 * c + x1 * s;
        }
#pragma unroll
        for (int j = 0; j < 2; ++j) {
            const int id = lane + 64 * j, hd = id >> 3, i = id & 7;
            float* q = p + O_IQ + hd * 64;
            float c, s; rope_cs(pos, i, 8, c, s);
            const float x1 = q[i], x2 = q[i + 8];
            q[i] = x1 * c - x2 * s; q[i + 8] = x2 * c + x1 * s;
        }
        {
            const float v = p[O_IK + lane];
            const float mean = wave_sum(v) * (1.f / 64.f);
            const float d = v - mean;
            const float var = wave_sum(d * d) * (1.f / 64.f);
            float y = d * (1.f / sqrtf(var + EPS)) * F.ikg[lane] + F.ikb[lane];
            const float other = __shfl_xor(y, 8);
            float c, s; rope_cs(pos, lane & 7, 8, c, s);
            if (lane < 8) y = y * c - other * s; else if (lane < 16) y = y * c + other * s;
            p[O_IK + lane] = y;
        }
        {
            float v[8]; float ss = 0.f;
#pragma unroll
            for (int j = 0; j < 8; ++j) { v[j] = p[O_QD + lane + 64 * j]; ss += v[j] * v[j]; }
            const float r = 1.f / sqrtf(wave_sum(ss) * (1.f / 512.f) + EPS);
#pragma unroll
            for (int j = 0; j < 8; ++j) p[O_QD + lane + 64 * j] = v[j] * r * F.qng[lane + 64 * j];
        }
        {
            float v[4]; float ss = 0.f;
#pragma unroll
            for (int j = 0; j < 4; ++j) { v[j] = p[O_KVD + lane + 64 * j]; ss += v[j] * v[j]; }
            const float r = 1.f / sqrtf(wave_sum(ss) * (1.f / 256.f) + EPS);
#pragma unroll
            for (int j = 0; j < 4; ++j) p[O_KVD + lane + 64 * j] = v[j] * r * F.kvng[lane + 64 * j];
        }
        {
            float y = p[O_KR + lane];
            const float other = __shfl_xor(y, 32);
            float c, s; rope_cs(pos, lane & 31, 32, c, s);
            y = (lane < 32) ? (y * c - other * s) : (y * c + other * s);
            p[O_KR + lane] = y;
        }
    }
}

DEVINL void p_qrope(Frame& F) {
    const int gw = F.bid * NWAVES + F.wave, NGW = F.G * NWAVES, lane = F.lane;
    for (int m = gw; m < NT; m += NGW) {
        float* p = F.qb + (size_t)m * 1536;
        const float pos = (float)F.pos[m];
#pragma unroll
        for (int j = 0; j < 4; ++j) {
            const int id = lane + 64 * j, hd = id >> 5, i = id & 31;
            float* q = p + hd * 192 + 128;
            float c, s; rope_cs(pos, i, 32, c, s);
            const float x1 = q[i], x2 = q[i + 32];
            q[i] = x1 * c - x2 * s; q[i + 32] = x2 * c + x1 * s;
        }
    }
}

DEVINL unsigned f2key(float f) { const unsigned u = __builtin_bit_cast(unsigned, f + 0.0f); return (u & 0x80000000u) ? ~u : (u | 0x80000000u); }
DEVINL void p_index(Frame& F, float* lds) {
    float* iqs = lds;
    float* iws = lds + 1024;
    unsigned* key = (unsigned*)(lds + 1040);
    unsigned* hist = key + 4096;
    unsigned* misc = hist + 256;
    const int tid = F.tid;
    for (int q = F.bid; q < NT; q += F.G) {
        const int b = q / S, t = q % S, ci = t >> 6, n = (ci + 1) * 64;
        const float* pq = F.proj + (size_t)q * INW;
        __syncthreads();
        for (int i = tid; i < 1024; i += NTHREADS) iqs[i] = pq[O_IQ + i];
        if (tid < 16) iws[tid] = pq[O_IW + tid];
        __syncthreads();
        for (int s = tid; s < n; s += NTHREADS) {
            const f32x4* kp = (const f32x4*)(F.proj + (size_t)(b * S + s) * INW + O_IK);
            f32x4 kr[16];
#pragma unroll
            for (int j = 0; j < 16; ++j) kr[j] = kp[j];
            float sc = 0.f;
            for (int h = 0; h < 16; ++h) {
                const f32x4* qh = (const f32x4*)(iqs + h * 64);
                float d = 0.f;
#pragma unroll
                for (int j = 0; j < 16; ++j) { const f32x4 qq = qh[j]; d += qq.x * kr[j].x + qq.y * kr[j].y + qq.z * kr[j].z + qq.w * kr[j].w; }
                sc += iws[h] * fmaxf(d, 0.f);
            }
            key[s] = f2key(sc * INDEX_SCALE);
        }
        __syncthreads();
        unsigned T = 0u;
        if (n > 256) {
            unsigned prefix = 0u, remaining = 256u;
            for (int pass = 0; pass < 4; ++pass) {
                const int shift = 24 - 8 * pass;
                if (tid < 256) hist[tid] = 0u;
                __syncthreads();
                for (int s = tid; s < n; s += NTHREADS) {
                    const unsigned kx = key[s];
                    if (pass == 0 || (kx >> (shift + 8)) == (prefix >> (shift + 8))) atomicAdd(&hist[(kx >> shift) & 255u], 1u);
                }
                __syncthreads();
                if (tid == 0) {
                    unsigned cum = 0u; int bin = 255;
                    for (; bin > 0; --bin) { if (cum + hist[bin] >= remaining) break; cum += hist[bin]; }
                    misc[0] = prefix | ((unsigned)bin << shift); misc[1] = remaining - cum; misc[2] = hist[bin];
                }
                __syncthreads();
                prefix = misc[0]; remaining = misc[1];
                __syncthreads();
            }
            T = prefix;
            const unsigned ties = misc[2];
            if (ties > remaining) {
                if (tid == 0) { unsigned keep = remaining; for (int s = 0; s < n; ++s) if (key[s] == T) { if (keep > 0u) --keep; else key[s] = 0u; } }
                __syncthreads();
            }
        }
        u64* mrow = F.mask + (size_t)q * 64;
        for (int w = F.wave; w < 64; w += NWAVES) {
            bool sel = false;
            if (w <= ci) sel = key[w * 64 + F.lane] >= T;
            const u64 bits = __ballot(sel);
            if (F.lane == 0) mrow[w] = bits;
        }
    }
}

template <int DQ1, int DQ2, bool MASK>
DEVINL void attn_unit_f32(float* lds, const float* q1, size_t ldq1, const float* q2, size_t ldq2, const float* k1, size_t ldk1, const float* k2, size_t ldk2,
                          const float* v, size_t ldv, const u64* mask, float* out, size_t ldo, int ci, float scale) {
    constexpr int DQ = DQ1 + DQ2, LQ = DQ + 4, LV = 132, LP = 36;
    float* Qs = lds;
    float* Ks = Qs + 64 * LQ;
    float* Vs = Ks + 32 * LQ;
    float* Ps = Vs + 32 * LV;
    const int tid = threadIdx.x;
    const int tq = tid >> 3, tk = tid & 7;
    __syncthreads();
    for (int idx = tid; idx < 64 * (DQ / 4); idx += NTHREADS) {
        const int row = idx / (DQ / 4), c4 = idx % (DQ / 4);
        f32x4 val;
        if (c4 < DQ1 / 4) val = *(const f32x4*)(q1 + (size_t)row * ldq1 + 4 * c4);
        else val = *(const f32x4*)(q2 + (size_t)row * ldq2 + 4 * (c4 - DQ1 / 4));
        *(f32x4*)(Qs + row * LQ + 4 * c4) = val;
    }
    float m = -1e30f, l = 0.f;
    f32x4 o[4];
#pragma unroll
    for (int i = 0; i < 4; ++i) o[i] = (f32x4){0.f, 0.f, 0.f, 0.f};
    const int ntiles = (ci + 1) * 2;
    for (int kt = 0; kt < ntiles; ++kt) {
        __syncthreads();
        for (int idx = tid; idx < 32 * (DQ / 4); idx += NTHREADS) {
            const int row = idx / (DQ / 4), c4 = idx % (DQ / 4); const size_t key = (size_t)kt * 32 + row;
            f32x4 val;
            if (c4 < DQ1 / 4) val = *(const f32x4*)(k1 + key * ldk1 + 4 * c4);
            else val = *(const f32x4*)(k2 + key * ldk2 + 4 * (c4 - DQ1 / 4));
            *(f32x4*)(Ks + row * LQ + 4 * c4) = val;
        }
        for (int idx = tid; idx < 32 * 32; idx += NTHREADS) {
            const int row = idx >> 5, c4 = idx & 31; const size_t key = (size_t)kt * 32 + row;
            *(f32x4*)(Vs + row * LV + 4 * c4) = *(const f32x4*)(v + key * ldv + 4 * c4);
        }
        __syncthreads();
        float s[4] = {0.f, 0.f, 0.f, 0.f};
        for (int d = 0; d < DQ; d += 4) {
            const f32x4 qq = *(const f32x4*)(Qs + tq * LQ + d);
#pragma unroll
            for (int j = 0; j < 4; ++j) { const f32x4 kk = *(const f32x4*)(Ks + (4 * tk + j) * LQ + d); s[j] += qq.x * kk.x + qq.y * kk.y + qq.z * kk.z + qq.w * kk.w; }
        }
        unsigned mbits = 0xFu;
        if (MASK) { const u64 w = mask[(size_t)tq * 64 + (kt >> 1)]; mbits = (unsigned)(w >> ((kt & 1) * 32 + 4 * tk)) & 0xFu; }
        float mx = -INFINITY;
#pragma unroll
        for (int j = 0; j < 4; ++j) { s[j] = ((mbits >> j) & 1u) ? s[j] * scale : -INFINITY; mx = fmaxf(mx, s[j]); }
        mx = fmaxf(mx, __shfl_xor(mx, 1)); mx = fmaxf(mx, __shfl_xor(mx, 2)); mx = fmaxf(mx, __shfl_xor(mx, 4));
        const float mn = fmaxf(m, mx), alpha = expf(m - mn);
        float ps = 0.f;
#pragma unroll
        for (int j = 0; j < 4; ++j) { const float p = expf(s[j] - mn); ps += p; Ps[tq * LP + 4 * tk + j] = p; }
        ps += __shfl_xor(ps, 1); ps += __shfl_xor(ps, 2); ps += __shfl_xor(ps, 4);
        l = l * alpha + ps; m = mn;
#pragma unroll
        for (int i = 0; i < 4; ++i) o[i] = o[i] * alpha;
        __syncthreads();
        for (int k = 0; k < 32; ++k) {
            const float p = Ps[tq * LP + k];
#pragma unroll
            for (int i = 0; i < 4; ++i) { const f32x4 vv = *(const f32x4*)(Vs + k * LV + 4 * (tk + 8 * i)); o[i] = o[i] + vv * p; }
        }
    }
    const float inv = 1.f / l;
#pragma unroll
    for (int i = 0; i < 4; ++i) *(f32x4*)(out + (size_t)tq * ldo + 4 * (tk + 8 * i)) = o[i] * inv;
}

DEVINL void p_attn(Frame& F, float* lds) {
    for (int u = F.bid; u < 4096; u += F.G) {
        const int kind = u >> 11, r = u & 2047, ci = 63 - (r >> 5), bh = r & 31, b = bh >> 3, hd = bh & 7;
        const size_t t0 = (size_t)b * S + (size_t)ci * 64, tb = (size_t)b * S;
        if (kind == 0) {
            attn_unit_f32<128, 0, true>(lds, F.proj + t0 * INW + O_AQ + hd * 128, INW, nullptr, 0, F.proj + tb * INW + O_AK + hd * 128, INW, nullptr, 0,
                                         F.proj + tb * INW + O_AV + hd * 128, INW, F.mask + t0 * 64, F.oab + t0 * D + hd * 128, D, ci, 0.08838834764831845f);
        } else {
            attn_unit_f32<128, 64, false>(lds, F.qb + t0 * 1536 + hd * 192, 1536, F.qb + t0 * 1536 + hd * 192 + 128, 1536, F.kv + tb * D + hd * 256, D, F.proj + tb * INW + O_KR, INW,
                                          F.kv + tb * D + hd * 256 + 128, D, nullptr, F.oab + t0 * D + 1024 + hd * 128, D, ci, 0.07216878364870322f);
        }
    }
}

DEVINL void p_merge(Frame& F) {
    const int gw = F.bid * NWAVES + F.wave, NGW = F.G * NWAVES;
    for (int m = gw; m < NT; m += NGW) {
#pragma unroll
        for (int half = 0; half < 2; ++half) {
            f32x4* p = (f32x4*)(F.oab + (size_t)m * D + half * 1024) + F.lane;
            const f32x4* g = (const f32x4*)(half ? F.onbg : F.onag) + F.lane;
            f32x4 v[4]; float ss = 0.f;
#pragma unroll
            for (int j = 0; j < 4; ++j) { v[j] = p[64 * j]; ss += (v[j].x * v[j].x + v[j].y * v[j].y) + (v[j].z * v[j].z + v[j].w * v[j].w); }
            const float r = 1.f / sqrtf(wave_sum(ss) * (1.f / 1024.f) + EPS);
#pragma unroll
            for (int j = 0; j < 4; ++j) p[64 * j] = v[j] * r * g[64 * j];
        }
    }
}

DEVINL void p_router(Frame& F, float* lds) {
    const int gw = F.bid * NWAVES + F.wave, NGW = F.G * NWAVES, lane = F.lane;
    for (int m = gw; m < NT; m += NGW) {
        const int b = m / S;
        f32x4* xr = (f32x4*)(F.x1 + (size_t)m * D) + lane;
        f32x4 v[8]; float s = 0.f;
#pragma unroll
        for (int j = 0; j < 8; ++j) { v[j] = xr[64 * j]; s += (v[j].x + v[j].y) + (v[j].z + v[j].w); }
        float mean = wave_sum(s) * (1.f / D); float s2 = 0.f;
#pragma unroll
        for (int j = 0; j < 8; ++j) { v[j] = v[j] - mean; s2 += (v[j].x * v[j].x + v[j].y * v[j].y) + (v[j].z * v[j].z + v[j].w * v[j].w); }
        float rstd = 1.f / sqrtf(wave_sum(s2) * (1.f / D) + EPS);
        const f32x4* g = (const f32x4*)F.lnmg + lane; const f32x4* bb = (const f32x4*)F.lnmb + lane;
        s = 0.f;
#pragma unroll
        for (int j = 0; j < 8; ++j) { v[j] = v[j] * rstd * g[64 * j] + bb[64 * j]; xr[64 * j] = v[j]; s += (v[j].x + v[j].y) + (v[j].z + v[j].w); }
        mean = wave_sum(s) * (1.f / D); s2 = 0.f;
#pragma unroll
        for (int j = 0; j < 8; ++j) { v[j] = v[j] - mean; s2 += (v[j].x * v[j].x + v[j].y * v[j].y) + (v[j].z * v[j].z + v[j].w * v[j].w); }
        rstd = 1.f / sqrtf(wave_sum(s2) * (1.f / D) + EPS);
        const f32x4* sh = (const f32x4*)(F.ada + (size_t)b * 6 * D + 3 * D) + lane;
        const f32x4* scp = (const f32x4*)(F.ada + (size_t)b * 6 * D + 4 * D) + lane;
        u32x2* ho = (u32x2*)(F.hA + (size_t)m * D) + lane; f32x4* hf = (f32x4*)(F.h + (size_t)m * D) + lane;
#pragma unroll
        for (int j = 0; j < 8; ++j) { v[j] = v[j] * rstd * (scp[64 * j] + 1.f) + sh[64 * j]; ho[64 * j] = (u32x2){pk_f16(v[j].x, v[j].y), pk_f16(v[j].z, v[j].w)}; hf[64 * j] = v[j]; }
        float* hs = lds + F.wave * D;
#pragma unroll
        for (int j = 0; j < 8; ++j) *(f32x4*)(hs + 4 * lane + 256 * j) = v[j];
        float part[32];
#pragma unroll
        for (int e = 0; e < 32; ++e) part[e] = 0.f;
#pragma unroll 1
        for (int i = 0; i < 32; ++i) {
            const int k = 4 * lane + 256 * (i >> 2) + (i & 3); const float hv = hs[k];
            const f32x4* wr = (const f32x4*)(F.w_router + (size_t)k * 32);
#pragma unroll
            for (int e4 = 0; e4 < 8; ++e4) { const f32x4 w = wr[e4]; part[4 * e4] += hv * w.x; part[4 * e4 + 1] += hv * w.y; part[4 * e4 + 2] += hv * w.z; part[4 * e4 + 3] += hv * w.w; }
        }
        float myv = -INFINITY;
#pragma unroll
        for (int e = 0; e < 32; ++e) { const float tot = wave_sum(part[e]); if (lane == e) myv = tot + F.b_router[e]; }
        int se[4]; float sv[4];
#pragma unroll
        for (int k = 0; k < 4; ++k) {
            float bv = myv; int bi = lane;
#pragma unroll
            for (int o = 1; o < 64; o <<= 1) { const float ov = __shfl_xor(bv, o); const int oi = __shfl_xor(bi, o); if (ov > bv || (ov == bv && oi < bi)) { bv = ov; bi = oi; } }
            se[k] = bi; sv[k] = bv; if (lane == bi) myv = -INFINITY;
        }
        const float e0 = 1.f, e1 = expf(sv[1] - sv[0]), e2 = expf(sv[2] - sv[0]), e3 = expf(sv[3] - sv[0]);
        const float inv = 1.f / (e0 + e1 + e2 + e3);
        if (lane < 4) {
            const int e = lane == 0 ? se[0] : lane == 1 ? se[1] : lane == 2 ? se[2] : se[3];
            const float gv = (lane == 0 ? e0 : lane == 1 ? e1 : lane == 2 ? e2 : e3) * inv;
            const unsigned p = atomicAdd(F.ctl + CW_CNT + e, 1u);
            F.list[(size_t)e * LISTCAP + p] = m * 4 + lane;
            F.tope[m * 4 + lane] = e; F.gate[m * 4 + lane] = gv;
        }
    }
}

struct MoeTab { int cnt[NE], tstart[NE + 1], offs[NE + 1]; };
DEVINL void moe_tab(Frame& F, MoeTab* tb) {
    __syncthreads();
    if (F.tid == 0) {
        int ts = 0, of = 0;
        for (int e = 0; e < NE; ++e) { const int c = (int)__hip_atomic_load(F.ctl + CW_CNT + e, __ATOMIC_RELAXED, __HIP_MEMORY_SCOPE_AGENT); tb->cnt[e] = c; tb->tstart[e] = ts; tb->offs[e] = of; ts += (c + 127) / 128; of += c; }
        tb->tstart[NE] = ts; tb->offs[NE] = of;
    }
    __syncthreads();
}
struct RowGatherH { const float* h; const int* lst; int r0, cnt; DEVINL const float* operator()(int r) const { int rr = r0 + r; rr = rr < cnt ? rr : cnt - 1; return h + (size_t)(lst[rr] >> 2) * D; } };
struct RowAct { const float* act; int base, r0, cnt; DEVINL const float* operator()(int r) const { int rr = r0 + r; rr = rr < cnt ? rr : cnt - 1; return act + (size_t)(base + rr) * DFF; } };

DEVINL void p_final(Frame& F) {
    const int gw = F.bid * NWAVES + F.wave, NGW = F.G * NWAVES, lane = F.lane;
    for (int m = gw; m < NT; m += NGW) {
        const int b = m / S;
        const f32x4* xr = (const f32x4*)(F.x1 + (size_t)m * D) + lane;
        const f32x4* g2 = (const f32x4*)(F.ada + (size_t)b * 6 * D + 5 * D) + lane;
        const f32x4* y0 = (const f32x4*)(F.y + (size_t)m * 4 * D) + lane;
        f32x4 v[8]; float s = 0.f;
#pragma unroll
        for (int j = 0; j < 8; ++j) {
            const f32x4 ys = ((y0[64 * j] + y0[512 + 64 * j]) + y0[1024 + 64 * j]) + y0[1536 + 64 * j];
            v[j] = xr[64 * j] * ALPHA + g2[64 * j] * ys; s += (v[j].x + v[j].y) + (v[j].z + v[j].w);
        }
        const float mean = wave_sum(s) * (1.f / D); float s2 = 0.f;
#pragma unroll
        for (int j = 0; j < 8; ++j) { v[j] = v[j] - mean; s2 += (v[j].x * v[j].x + v[j].y * v[j].y) + (v[j].z * v[j].z + v[j].w * v[j].w); }
        const float rstd = 1.f / sqrtf(wave_sum(s2) * (1.f / D) + EPS);
        const f32x4* g = (const f32x4*)F.lnfg + lane; const f32x4* bb = (const f32x4*)F.lnfb + lane;
        f32x4* o = (f32x4*)(F.out + (size_t)m * D) + lane;
#pragma unroll
        for (int j = 0; j < 8; ++j) o[64 * j] = v[j] * rstd * g[64 * j] + bb[64 * j];
    }
}

struct EpiStore { float* C; size_t ldc; int m0, N; DEVINL void operator()(int row, int col, float v) const { if (col < N) C[(size_t)(m0 + row) * ldc + col] = v; } };
struct EpiPre { float* C; const float* x; const float* g1; int m0; DEVINL void operator()(int row, int col, float v) const { const size_t i = (size_t)(m0 + row) * D + col; C[i] = ALPHA * x[i] + g1[col] * v; } };
struct EpiGU { float* act; const float* bias; int base, r0, cnt, lane; DEVINL void operator()(int row, int col, float v) const {
        const float t = v + bias[col]; const float o = __shfl_xor(t, 1);
        if (!(lane & 1) && r0 + row < cnt) { float g = fminf(t, 7.0f); float u = fminf(fmaxf(o, -7.0f), 7.0f); const float sg = 1.f / (1.f + expf(-1.702f * g)); act[(size_t)(base + r0 + row) * DFF + (col >> 1)] = (u + 1.f) * (g * sg); } } };
struct EpiDown { float* y; const float* bias; const int* lst; const float* gate; int r0, cnt; DEVINL void operator()(int row, int col, float v) const {
        if (r0 + row < cnt) { const int aid = lst[r0 + row]; y[(size_t)aid * D + col] = (v + bias[col]) * gate[aid]; } } };


DEVINL int permA(int d) { return 8 * ((d & 15) >> 2) + 4 * (d >> 4) + (d & 3); }
DEVINL int permI(int d) { return d < 16 ? 8 * ((d & 7) >> 2) + 4 * (d >> 3) + (d & 3) : 8 * (2 + (((d - 16) & 7) >> 2)) + 4 * ((d - 16) >> 3) + (d & 3); }
DEVINL int permR(int d) { const int n = d >> 5, r = d & 31; return 32 * (r >> 4) + 8 * ((r & 15) >> 2) + 4 * n + (r & 3); }
DEVINL int vcol_in(int p) {
    if (p < 2048) { const int d = p & 127; return (p & ~127) + (d < 32 ? permA(d) : d); }
    if (p < 3072) return p;
    if (p < 4096) { const int d = p & 63; return (p & ~63) + (d < 32 ? permI(d) : d); }
    if (p < 4160) { const int d = p - 4096; return d < 32 ? V_IK_LO + permI(d) : V_IK_HI + (d - 32); }
    if (p < 4176) return V_IW + (p - 4160);
    if (p < 4688) return V_QD + (p - 4176);
    if (p < 4944) return V_KVD + (p - 4688);
    return V_KR + permR(p - 4944);
}
#define LDS_WAIT() asm volatile("s_waitcnt lgkmcnt(0)" ::: "memory")

template <class Map>
DEVINL void transpose_item(const float* __restrict__ W, int N, f16* __restrict__ WT, int ldt, const float* __restrict__ kscale, const Map& map, LAS float* scr, int item, int lane) {
    const int nblk = (N + 63) / 64, kb = item / nblk, nb = item % nblk, k0 = 64 * kb, n0 = 64 * nb;
    f32x4 v[16];
    const int n4 = (lane & 15) * 4;
#pragma unroll
    for (int i = 0; i < 16; ++i) {
        const int k = 4 * i + (lane >> 4);
        v[i] = (f32x4){0.f, 0.f, 0.f, 0.f};
        if (n0 + n4 < N) v[i] = *(const f32x4*)(W + (size_t)(k0 + k) * N + n0 + n4);
    }
#pragma unroll
    for (int i = 0; i < 16; ++i) {
        const int k = 4 * i + (lane >> 4);
        if (kscale) v[i] = v[i] * kscale[k0 + k];
        scr[k * 65 + n4] = v[i].x; scr[k * 65 + n4 + 1] = v[i].y; scr[k * 65 + n4 + 2] = v[i].z; scr[k * 65 + n4 + 3] = v[i].w;
    }
    LDS_WAIT();
    const int c = lane & 7;
#pragma unroll
    for (int j = 0; j < 8; ++j) {
        const int n = (lane >> 3) + 8 * j;
        const int dr = (n0 + n < N) ? map(n0 + n) : -1;
        const LAS float* sp = scr + (8 * c) * 65 + n;
        u32x4 o; o.x = pk_f16(sp[0], sp[65]); o.y = pk_f16(sp[2 * 65], sp[3 * 65]); o.z = pk_f16(sp[4 * 65], sp[5 * 65]); o.w = pk_f16(sp[6 * 65], sp[7 * 65]);
        if (dr >= 0) *(u32x4*)(WT + (size_t)dr * ldt + k0 + 8 * c) = o;
    }
    LDS_WAIT();
}

constexpr float W8_SCALE = 64.f, W8_INV = 1.f / 64.f;
DEVINL unsigned pk4_fp8(float a, float b, float c, float d) { int p = __builtin_amdgcn_cvt_pk_fp8_f32(a, b, 0, false); p = __builtin_amdgcn_cvt_pk_fp8_f32(c, d, p, true); return (unsigned)p; }
DEVINL void ti8_load(const float* __restrict__ W, int N, int item, int lane, f32x4 (&v)[16]) {
    const int nblk = N / 32, kb = item / nblk, nb = item % nblk, k0 = 128 * kb, n0 = 32 * nb, n4 = (lane & 7) * 4;
#pragma unroll
    for (int i = 0; i < 16; ++i) { const int k = 8 * i + (lane >> 3); v[i] = __builtin_nontemporal_load((const f32x4*)(W + (size_t)(k0 + k) * N + n0 + n4)); }
}
DEVINL void ti8_put(const f32x4 (&v)[16], LAS float* scr, int lane, const float* __restrict__ kscale = nullptr, int k0 = 0) {
    LAS unsigned* wp = (LAS unsigned*)scr + (lane & 7) * 136 + (lane >> 3);
#pragma unroll
    for (int i = 0; i < 16; ++i) { const float sc = kscale ? W8_SCALE * kscale[k0 + 8 * i + (lane >> 3)] : W8_SCALE; wp[8 * i] = pk4_fp8(v[i].x * sc, v[i].y * sc, v[i].z * sc, v[i].w * sc); }
    LDS_WAIT();
}
template <class RowOf>
DEVINL void ti8_flush8(unsigned char* WT, int ldt, int kb, int n0, const RowOf& rowof, LAS float* scr, int lane) {
    const int gl = lane >> 4, c = lane & 15;
#pragma unroll
    for (int p = 0; p < 2; ++p) {
        const int g = 4 * p + gl;
        const LAS u32x4* sp = (const LAS u32x4*)((LAS unsigned*)scr + g * 136 + 8 * c);
        const u32x4 q0 = sp[0], q1 = sp[1];
        const unsigned x0 = __builtin_amdgcn_perm(q0.y, q0.x, 0x05010400u), x1 = __builtin_amdgcn_perm(q0.y, q0.x, 0x07030602u), y0 = __builtin_amdgcn_perm(q0.w, q0.z, 0x05010400u), y1 = __builtin_amdgcn_perm(q0.w, q0.z, 0x07030602u);
        const unsigned z0 = __builtin_amdgcn_perm(q1.y, q1.x, 0x05010400u), z1 = __builtin_amdgcn_perm(q1.y, q1.x, 0x07030602u), w0 = __builtin_amdgcn_perm(q1.w, q1.z, 0x05010400u), w1 = __builtin_amdgcn_perm(q1.w, q1.z, 0x07030602u);
        const u32x2 o0 = {__builtin_amdgcn_perm(y0, x0, 0x05040100u), __builtin_amdgcn_perm(w0, z0, 0x05040100u)}, o1 = {__builtin_amdgcn_perm(y0, x0, 0x07060302u), __builtin_amdgcn_perm(w0, z0, 0x07060302u)};
        const u32x2 o2 = {__builtin_amdgcn_perm(y1, x1, 0x05040100u), __builtin_amdgcn_perm(w1, z1, 0x05040100u)}, o3 = {__builtin_amdgcn_perm(y1, x1, 0x07060302u), __builtin_amdgcn_perm(w1, z1, 0x07060302u)};
        typedef __attribute__((address_space(1))) u32x2 gu32x2;
        const int nn = n0 + 4 * g;
        auto at = [&](int row) { return WT + ((size_t)(row >> 8) * (ldt >> 7) + kb) * 32768 + (row & 255) * 128 + 8 * c; };
        *(gu32x2*)at(rowof(nn)) = o0; *(gu32x2*)at(rowof(nn + 1)) = o1; *(gu32x2*)at(rowof(nn + 2)) = o2; *(gu32x2*)at(rowof(nn + 3)) = o3;
    }
    LDS_WAIT();
}
struct MapIn { DEVINL int operator()(int n) const { return vcol_in(n); } };
struct MapId { DEVINL int operator()(int n) const { return n; } };
struct MapQup { DEVINL int operator()(int n) const { const int h = n / 192, d = n - h * 192; return h * 192 + (d < 128 ? d : 128 + permR(d - 128)); } };
struct MapGU { DEVINL int operator()(int n) const { const int j = n >> 1; return 256 * (j >> 7) + (j & 127) + 128 * (n & 1); } };

DEVINL void p_moeconv(Frame& F, float* lds, int gw_, int NGW, int first = 0, int cnt = 1 << 30) {
    const int gw = __builtin_amdgcn_readfirstlane(gw_) + first * NGW;
    LAS float* scr = (LAS float*)lds + F.wave * 4352;
    const int lane = F.lane;
    constexpr int I_GU = (D / 128) * (2 * DFF / 32), I_DN = (DFF / 128) * (D / 32), I_E = I_GU + I_DN, I_MOE = NE * I_E;
    if (gw >= I_MOE) return;
    const int nall = (I_MOE - gw + NGW - 1) / NGW, nsteps = nall < cnt ? nall : cnt, n3 = (nsteps + 2) / 3 * 3;
    const float* const w_gu = F.w_gu; const float* const w_dn = F.w_dn; unsigned char* const WguT = (unsigned char*)F.WguT; unsigned char* const WdT = (unsigned char*)F.WdT;
    auto load = [&](f32x4 (&v)[16], int step, int lo, int hi) {
        const int it = gw + (step < nsteps ? step : nsteps - 1) * NGW, e = it / I_E, r = it - e * I_E;
        const bool gu = r < I_GU;
        const float* W = gu ? w_gu + (size_t)e * D * 2 * DFF : w_dn + (size_t)e * DFF * D;
        const int N = gu ? 2 * DFF : D, sh = gu ? 7 : 6, il = gu ? r : r - I_GU, kb = il >> sh, nb = il - (kb << sh);
        const unsigned long long wa = (unsigned long long)W;
        const u32x4 rs = {(unsigned)__builtin_amdgcn_readfirstlane((int)(unsigned)wa), (unsigned)__builtin_amdgcn_readfirstlane((int)(unsigned)(wa >> 32)) & 0xffffu, 0xffffffffu, 0x00020000u};
        const int vo = ((lane >> 3) * N + (lane & 7) * 4) * 4, so = (128 * kb * N + 32 * nb) * 4;
#pragma unroll
        for (int i = lo; i < hi; ++i) { const int soi = __builtin_amdgcn_readfirstlane(so + 8 * i * N * 4); asm volatile("buffer_load_dwordx4 %0, %1, %2, %3 offen nt" : "=v"(v[i]) : "v"(vo), "s"(rs), "s"(soi) : "memory"); }
    };
    auto flush = [&](int step) {
        const int it = gw + (step < nsteps ? step : nsteps - 1) * NGW, e = it / I_E, r = it - e * I_E;
        const bool gu = r < I_GU;
        unsigned char* WT = gu ? WguT + (size_t)e * 2 * DFF * D : WdT + (size_t)e * D * DFF;
        const int ldt = gu ? D : DFF, sh = gu ? 7 : 6, il = gu ? r : r - I_GU, kb = il >> sh, nb = il - (kb << sh);
        ti8_flush8(WT, ldt, kb, 32 * nb, [gu](int nn) { return gu ? MapGU()(nn) : nn; }, scr, lane);
    };
#define MOE_WAIT(v_, n_) asm volatile("s_waitcnt vmcnt(" #n_ ")" : "+v"(v_[0]), "+v"(v_[1]), "+v"(v_[2]), "+v"(v_[3]), "+v"(v_[4]), "+v"(v_[5]), "+v"(v_[6]), "+v"(v_[7]), \
        "+v"(v_[8]), "+v"(v_[9]), "+v"(v_[10]), "+v"(v_[11]), "+v"(v_[12]), "+v"(v_[13]), "+v"(v_[14]), "+v"(v_[15]) :: "memory")
#define MOE_STEP(vcur_, vnxt_, st_) do { load(vnxt_, (st_) + 2, 0, 8); MOE_WAIT(vcur_, 40); ti8_put(vcur_, scr, lane); __builtin_amdgcn_sched_barrier(0); \
        load(vnxt_, (st_) + 2, 8, 16); __builtin_amdgcn_sched_barrier(0); flush(st_); } while (0)
    f32x4 va[16], vb[16], vc[16];
    load(va, 0, 0, 16); load(vb, 1, 0, 16);
    MOE_WAIT(va, 0); MOE_WAIT(vb, 0);
#pragma unroll 1
    for (int st = 0; st < n3; st += 3) { MOE_STEP(va, vc, st); MOE_STEP(vb, va, st + 1); MOE_STEP(vc, vb, st + 2); }
#undef MOE_STEP
#undef MOE_WAIT
    asm volatile("s_waitcnt vmcnt(0)" ::: "memory");
}

DEVINL void p_prologue(Frame& F, float* lds, int gw, int NGW) {
    LAS float* scr = (LAS float*)lds + F.wave * 4352;
    const int lane = F.lane;
    constexpr int I_IN = (D / 64) * ((INW + 63) / 64);
    for (int it = gw; it < I_IN; it += NGW) transpose_item(F.w_in, INW, F.WinT, D, nullptr, MapIn(), scr, it, lane);
    {
        constexpr int I_OUT = (D / 64) * (D / 64), I_GU = (D / 128) * (2 * DFF / 32), I_DN = (DFF / 128) * (D / 32), I_MOE = NE * (I_GU + I_DN);
#if OUTPROJ_F8
        for (int it = gw; it < (D / 128) * (D / 32); it += NGW) {
            f32x4 vo[16]; ti8_load(F.w_out, D, it, lane, vo);
            const int k0 = 128 * (it / (D / 32));
            ti8_put(vo, scr, lane, k0 < 1024 ? F.onag : F.onbg - 1024, k0); ti8_flush8((unsigned char*)F.WoutT, D, k0 >> 7, 32 * (it % (D / 32)), MapId(), scr, lane);
        }
#else
        for (int it = gw; it < I_OUT; it += NGW) { const int k0 = 64 * (it / (D / 64)); transpose_item(F.w_out, D, F.WoutT, D, k0 < 1024 ? F.onag : F.onbg - 1024, MapId(), scr, it, lane); }
#endif
        for (int i = gw * 64 + lane; i < NE * 2 * DFF; i += NGW * 64) { const int e = i >> 12, v = i & 4095, t = v >> 8, w = v & 255; F.bguP[i] = F.b_gu[(size_t)e * 2 * DFF + 2 * (128 * t + (w & 127)) + (w >> 7)]; }
    }
    {   constexpr int I_QU = (512 / 64) * (1536 / 64), I_KV = (256 / 64) * (2048 / 64);
        for (int it = gw; it < I_QU + I_KV; it += NGW) {
            if (it < I_QU) transpose_item(F.w_q_up, 1536, F.WqupT, 512, F.qng, MapQup(), scr, it, lane);
            else transpose_item(F.w_kv_up, 2048, F.WkvupT, 256, F.kvng, MapId(), scr, it - I_QU, lane);
        }
    }
    for (int i = gw * 64 + lane; i < NE * D; i += NGW * 64) { const int e = i >> 11, k = i & 2047; F.WrT[i] = (f16)F.w_router[(size_t)k * NE + e]; }
    if (gw == 0) { const int v = lane < 32 ? permI(lane) : lane; F.ikv[v] = F.ikg[lane]; F.ikv[64 + v] = F.ikb[lane]; }
    for (int i = gw * 64 + lane; i < 16 * D / 8; i += NGW * 64) ((u32x4*)(F.WinT + (size_t)4912 * D))[i] = (u32x4){0u, 0u, 0u, 0u};
    for (int i = gw * 64 + lane; i < (NV - 5024) * D / 8; i += NGW * 64) ((u32x4*)(F.WinT + (size_t)5024 * D))[i] = (u32x4){0u, 0u, 0u, 0u};
    for (int m = gw; m < NT; m += NGW) {
        const int b = m / S;
        const f32x4* xr = (const f32x4*)(F.x + (size_t)m * D) + lane;
        f32x4 v[8]; float s = 0.f;
#pragma unroll
        for (int j = 0; j < 8; ++j) { v[j] = xr[64 * j]; s += (v[j].x + v[j].y) + (v[j].z + v[j].w); }
        const float mean = wave_sum(s) * (1.f / D); float s2 = 0.f;
#pragma unroll
        for (int j = 0; j < 8; ++j) { v[j] = v[j] - mean; s2 += (v[j].x * v[j].x + v[j].y * v[j].y) + (v[j].z * v[j].z + v[j].w * v[j].w); }
        const float rstd = 1.f / sqrtf(wave_sum(s2) * (1.f / D) + EPS);
        const f32x4* sh = (const f32x4*)(F.ada + (size_t)b * 6 * D) + lane;
        const f32x4* scp = (const f32x4*)(F.ada + (size_t)b * 6 * D + D) + lane;
        u32x2* o = (u32x2*)(F.hA + (size_t)m * D) + lane;
#pragma unroll
        for (int j = 0; j < 8; ++j) { const f32x4 y = v[j] * rstd * (scp[64 * j] + 1.f) + sh[64 * j]; o[64 * j] = (u32x2){pk_f16(y.x, y.y), pk_f16(y.z, y.w)}; }
        if (lane < 56) {
            const float pos = (float)F.pos[m];
            int i, half, oc, os;
            if (lane < 16) { i = lane; half = 16; oc = T_CA; os = T_SA; } else if (lane < 24) { i = lane - 16; half = 8; oc = T_CI; os = T_SI; } else { i = lane - 24; half = 32; oc = T_CR; os = T_SR; }
            float c, sn; rope_cs(pos, i, half, c, sn);
            F.tab[(size_t)m * TABW + oc + i] = c; F.tab[(size_t)m * TABW + os + i] = sn;
        }
    }
}

namespace g16 {
constexpr int BM = 256, BK = 64, HALF = 128, HTB = HALF * BK * 2, STAGE_BYTES = 8 * HTB, NXCD = 8, WGM = 8;
DEVINL int lds_byte(int r, int c) { const int st = (r >> 4) * 2 + (c >> 5), rr = r & 15, cc = c & 31, ob = rr * 64 + cc * 2; return st * 1024 + (ob ^ (((ob >> 9) & 1) << 5)); }
DEVINL void stage_rc(int b, int& R, int& C) { const int st = b / 1024, sb = b % 1024, swz = sb ^ (((sb >> 9) & 1) << 5); R = (st >> 1) * 16 + swz / 64; C = (st & 1) * 32 + (swz % 64) / 2; }
DEVINL int perm32(int rho) { const int n = rho >> 4, i = rho & 15; return 8 * (i >> 2) + 4 * n + (i & 3); }
struct Unit { int pm, pn, aux; };
struct Gemm { const f16* A; const f16* Bt; int lda, ldb, K; int btiled = 0; };
struct StaticOrder {
    static constexpr bool GATHER = false;
    int nM, nN, nwg, G, c, wgm;
    DEVINL void init(int M, int N, int G_, int c_, int wgm_ = WGM) { nM = M / BM; nN = N / BM; nwg = nM * nN; G = G_; c = c_; wgm = wgm_; }
    DEVINL bool next(int i, Unit& u) const {
        const long L = (long)i * G + c; if (L >= nwg) return false;
        int wgid = (int)L; { const int q = nwg / NXCD, r = nwg % NXCD, xcd = wgid % NXCD, off = wgid / NXCD; wgid = (xcd < r ? xcd * (q + 1) : r * (q + 1) + (xcd - r) * q) + off; }
        const int nig = wgm * nN, gid = wgid / nig, fm = gid * wgm, gsz = (nM - fm) < wgm ? (nM - fm) : wgm;
        u.pm = fm + ((wgid % nig) % gsz); u.pn = (wgid % nig) / gsz; u.aux = 0; return true;
    }
    DEVINL int arow(const Unit&, int) const { return 0; }
};
typedef int i32x8 __attribute__((ext_vector_type(8)));
template <class Epi, class Sched, bool ALIGN_EPI = true, bool F8 = false>
DEVINL void gemm_phase(LAS unsigned char* lds, const Gemm g, const Sched& S, const Epi& E) {
    int tid_ = threadIdx.x; asm volatile("" : "+v"(tid_));
    const int tid = tid_, wid = __builtin_amdgcn_readfirstlane(tid >> 6), lane = tid & 63, wr = wid >> 2, wc = wid & 3, fr = lane & 15, fq = lane >> 4;
    const int K = g.K, nt = K / BK;
    constexpr bool GA = Sched::GATHER;
    int RA[2], CA[2];
    unsigned voffB[2], offA[2][2], offAn[2][2];
#pragma unroll
    for (int i = 0; i < 2; ++i) { int R, C; stage_rc(tid * 16 + i * 8192, R, C); const int Rb = Epi::PERM ? ((R & ~31) + perm32(R & 31)) : R;
        RA[i] = R; CA[i] = C; voffB[i] = (unsigned)(Rb * (g.btiled ? BK : g.ldb) + C) * 2u;
        offA[0][i] = (unsigned)(R * g.lda + C) * 2u; offA[1][i] = (unsigned)((R + HALF) * g.lda + C) * 2u; offAn[0][i] = offA[0][i]; offAn[1][i] = offA[1][i]; }
    const size_t kstep = (size_t)(BK * 2);
    const size_t kstepB = g.btiled ? (size_t)(BM * BK * 2) : kstep, hstepB = g.btiled ? (size_t)(HALF * BK * 2) : (size_t)HALF * g.ldb * 2, tstepB = (size_t)BM * g.ldb * 2, tstepA = (size_t)BM * g.lda * 2;
    const unsigned ldsw = (unsigned)wid * 1024u;
    const int aoff = lds_byte(wr * 64 + fr, fq * 8), boff = lds_byte(wc * 32 + fr, fq * 8);
#define PG8_SA(b, h) (((b) * 2 + (h)) * HTB)
#define PG8_SB(b, h) ((4 + (b) * 2 + (h)) * HTB)
    const auto rsA = __builtin_amdgcn_make_buffer_rsrc((void*)g.A, 0, -1, 0x00020000), rsB = __builtin_amdgcn_make_buffer_rsrc((void*)g.Bt, 0, -1, 0x00020000);
#define PG8_STAGE_X(bufoff, rs, base0, gbase, voff) do { const int so_ = (int)(unsigned)((const char*)(gbase) - (const char*)(base0)); _Pragma("unroll") for (int _i = 0; _i < 2; ++_i) \
        __builtin_amdgcn_raw_ptr_buffer_load_lds(rs, (LAS unsigned*)(lds + (bufoff) + ldsw + _i * 8192), 16, (int)(voff)[_i], so_, 0, 0); } while (0)
#define PG8_STAGE(bufoff, gbase, voff) do { if constexpr (((bufoff) / HTB) < 4) PG8_STAGE_X(bufoff, rsA, g.A, gbase, voff); else PG8_STAGE_X(bufoff, rsB, g.Bt, gbase, voff); } while (0)
#define PG8_LD32(p) ({ const u32x4 lo_ = *(const LAS u32x4*)(p), hi_ = *(const LAS u32x4*)((p) + 1024); (i32x8){(int)lo_.x, (int)lo_.y, (int)lo_.z, (int)lo_.w, (int)hi_.x, (int)hi_.y, (int)hi_.z, (int)hi_.w}; })
#define PG8_LDA(dst, b, h) do { if constexpr (F8) { _Pragma("unroll") for (int m = 0; m < 4; ++m) dst##8[m] = PG8_LD32(lds + PG8_SA(b, h) + aoff + m * 2048); } \
        else { _Pragma("unroll") for (int m = 0; m < 4; ++m) _Pragma("unroll") for (int k = 0; k < 2; ++k) dst[m][k] = *(const LAS f16x8*)(lds + PG8_SA(b, h) + aoff + m * 2048 + k * 1024); } } while (0)
#define PG8_LDB(dst, b, h) do { if constexpr (F8) { _Pragma("unroll") for (int n = 0; n < 2; ++n) dst##8[n] = PG8_LD32(lds + PG8_SB(b, h) + boff + n * 2048); } \
        else { _Pragma("unroll") for (int n = 0; n < 2; ++n) _Pragma("unroll") for (int k = 0; k < 2; ++k) dst[n][k] = *(const LAS f16x8*)(lds + PG8_SB(b, h) + boff + n * 2048 + k * 1024); } } while (0)
#define PG8_MMA(ai, bj, At, Bt) do { __builtin_amdgcn_s_setprio(1); _Pragma("unroll") for (int m = 0; m < 4; ++m) _Pragma("unroll") for (int n = 0; n < 2; ++n) { \
        if constexpr (F8) asm volatile("v_mfma_scale_f32_16x16x128_f8f6f4 %0, %1, %2, %0, %3, %3 op_sel_hi:[0,0,0]" : "+v"(acc[ai][bj][m][n]) : "v"(Bt##8[n]), "v"(At##8[m]), "v"(one8)); \
        else { _Pragma("unroll") for (int k = 0; k < 2; ++k) acc[ai][bj][m][n] = __builtin_amdgcn_mfma_f32_16x16x32_f16(Bt[n][k], At[m][k], acc[ai][bj][m][n], 0, 0, 0); } } __builtin_amdgcn_s_setprio(0); } while (0)
#define PG8_WAIT_V(n) asm volatile("s_waitcnt vmcnt(" #n ")" ::: "memory")
#define PG8_WAIT_L(n) asm volatile("s_waitcnt lgkmcnt(" #n ")" ::: "memory")
#define PG8_BAR __builtin_amdgcn_s_barrier()
#define PG8_SCHED __builtin_amdgcn_sched_barrier(0)
    Unit cur, nxt; int ui = 0;
    if (!S.next(0, cur)) return;
    f32x4 acc[2][2][4][2];
#pragma unroll
    for (int a = 0; a < 2; ++a)
#pragma unroll
        for (int b = 0; b < 2; ++b)
#pragma unroll
            for (int m = 0; m < 4; ++m)
#pragma unroll
                for (int n = 0; n < 2; ++n) acc[a][b][m][n] = (f32x4){0.f, 0.f, 0.f, 0.f};
    f16x8 At[4][2], B0[2][2], B1[2][2];
    i32x8 At8[4], B08[2], B18[2];
    int one8 = 127; asm volatile("" : "+v"(one8));
    const char* cA = GA ? (const char*)g.A : (const char*)g.A + (size_t)cur.pm * tstepA; const char* cB = (const char*)g.Bt + (size_t)cur.pn * tstepB;
    if constexpr (GA) {
#pragma unroll
        for (int h = 0; h < 2; ++h)
#pragma unroll
            for (int i = 0; i < 2; ++i) offA[h][i] = (unsigned)S.arow(cur, h * HALF + RA[i]) * (unsigned)(g.lda * 2) + (unsigned)(CA[i] * 2);
    }
    PG8_STAGE(PG8_SB(0, 0), cB, voffB); PG8_STAGE(PG8_SB(0, 1), cB + hstepB, voffB); PG8_STAGE(PG8_SA(0, 0), cA, offA[0]); PG8_STAGE(PG8_SA(0, 1), cA, offA[1]);
    if (wr == 1) PG8_BAR;
    PG8_WAIT_V(2); PG8_BAR;
    PG8_STAGE(PG8_SB(1, 0), cB + kstepB, voffB); PG8_STAGE(PG8_SA(1, 0), cA + kstep, offA[0]); PG8_STAGE(PG8_SB(1, 1), cB + hstepB + kstepB, voffB);
    PG8_WAIT_V(6); PG8_BAR;
    for (;;) {
        const bool has_next = S.next(ui + 1, nxt);
        const char* nA = has_next ? (GA ? (const char*)g.A : (const char*)g.A + (size_t)nxt.pm * tstepA) : cA; const char* nB = has_next ? (const char*)g.Bt + (size_t)nxt.pn * tstepB : cB;
        if constexpr (GA) {
#pragma unroll
            for (int h = 0; h < 2; ++h)
#pragma unroll
                for (int i = 0; i < 2; ++i) offAn[h][i] = has_next ? (unsigned)S.arow(nxt, h * HALF + RA[i]) * (unsigned)(g.lda * 2) + (unsigned)(CA[i] * 2) : offA[h][i];
        }
#pragma unroll 1
        for (int t = 0; t < nt; t += 2) {
            const bool last = (t == nt - 2);
            const char* a1 = cA + (size_t)(t + 1) * kstep;
            const char* a2 = last ? nA : cA + (size_t)(t + 2) * kstep; const char* b2 = last ? nB : cB + (size_t)(t + 2) * kstepB;
            const char* a3 = a2 + kstep; const char* b3 = b2 + kstepB;
            unsigned o2[2][2];
#pragma unroll
            for (int h = 0; h < 2; ++h)
#pragma unroll
                for (int i = 0; i < 2; ++i) o2[h][i] = (GA && last) ? offAn[h][i] : offA[h][i];
            PG8_LDB(B0, 0, 0); PG8_LDB(B1, 0, 1); PG8_SCHED; PG8_LDA(At, 0, 0); PG8_STAGE(PG8_SA(1, 1), a1, offA[1]);
            PG8_WAIT_V(8); PG8_WAIT_L(0); PG8_BAR; PG8_MMA(0, 0, At, B0); PG8_MMA(0, 1, At, B1); PG8_BAR; PG8_SCHED;
            PG8_LDA(At, 0, 1); PG8_STAGE(PG8_SB(0, 0), b2, voffB); PG8_STAGE(PG8_SB(0, 1), b2 + hstepB, voffB); PG8_STAGE(PG8_SA(0, 0), a2, o2[0]);
            PG8_WAIT_V(8); PG8_WAIT_L(0); PG8_BAR; PG8_MMA(1, 0, At, B0); PG8_MMA(1, 1, At, B1); PG8_BAR; PG8_SCHED;
            PG8_LDB(B0, 1, 0); PG8_LDB(B1, 1, 1); PG8_SCHED; PG8_LDA(At, 1, 0); PG8_STAGE(PG8_SA(0, 1), a2, o2[1]);
            PG8_WAIT_V(8); PG8_WAIT_L(0); PG8_BAR; PG8_MMA(0, 0, At, B0); PG8_MMA(0, 1, At, B1); PG8_BAR; PG8_SCHED;
            PG8_LDA(At, 1, 1); PG8_STAGE(PG8_SB(1, 0), b3, voffB); PG8_STAGE(PG8_SB(1, 1), b3 + hstepB, voffB); PG8_STAGE(PG8_SA(1, 0), a3, o2[0]);
            PG8_WAIT_V(8); PG8_WAIT_L(0); PG8_BAR; PG8_MMA(1, 0, At, B0); PG8_MMA(1, 1, At, B1); PG8_BAR; PG8_SCHED;
        }
        if constexpr (ALIGN_EPI) { if (wr == 0) PG8_BAR; }
        if constexpr (F8) asm volatile("s_nop 15\n\ts_nop 15\n\ts_nop 7" ::: "memory");
        E(acc, cur, wr, wc, fr, fq);
        if (!has_next) break;
#pragma unroll
        for (int a = 0; a < 2; ++a)
#pragma unroll
            for (int b = 0; b < 2; ++b)
#pragma unroll
                for (int m = 0; m < 4; ++m)
#pragma unroll
                    for (int n = 0; n < 2; ++n) acc[a][b][m][n] = (f32x4){0.f, 0.f, 0.f, 0.f};
        cur = nxt; cA = nA; cB = nB; ++ui;
        if constexpr (GA) {
#pragma unroll
            for (int h = 0; h < 2; ++h)
#pragma unroll
                for (int i = 0; i < 2; ++i) offA[h][i] = offAn[h][i];
        }
        if constexpr (ALIGN_EPI) { if (wr == 1) PG8_BAR; }
    }
    PG8_WAIT_V(0);
    if constexpr (!ALIGN_EPI) { if (wr == 0) PG8_BAR; }
    PG8_BAR;
#undef PG8_SA
#undef PG8_SB
#undef PG8_STAGE
#undef PG8_STAGE_X
#undef PG8_LDA
#undef PG8_LDB
#undef PG8_MMA
#undef PG8_LD32
#undef PG8_WAIT_V
#undef PG8_WAIT_L
#undef PG8_BAR
#undef PG8_SCHED
}
}

struct EpiPlain {
    static constexpr bool PERM = true;
    f16* P;
    DEVINL void operator()(const f32x4 (&acc)[2][2][4][2], const g16::Unit& u, int wr, int wc, int fr, int fq) const {
#pragma unroll
        for (int bj = 0; bj < 2; ++bj)
#pragma unroll
            for (int ai = 0; ai < 2; ++ai)
#pragma unroll
                for (int m = 0; m < 4; ++m) {
                    const int row = u.pm * 256 + ai * 128 + wr * 64 + m * 16 + fr;
                    const f32x4 v0 = acc[ai][bj][m][0], v1 = acc[ai][bj][m][1];
                    u32x4 w; w.x = pk_f16(v0.x, v0.y); w.y = pk_f16(v0.z, v0.w); w.z = pk_f16(v1.x, v1.y); w.w = pk_f16(v1.z, v1.w);
                    *(u32x4*)(P + (size_t)row * NV + u.pn * 256 + bj * 128 + wc * 32 + 8 * fq) = w;
                }
    }
};
struct EpiInProj {
    static constexpr bool PERM = true;
    f16* P; const float* tab; float* ssq; float* sskv; const float* ikv;
    DEVINL void operator()(const f32x4 (&acc)[2][2][4][2], const g16::Unit& u, int wr, int wc, int fr, int fq) const {
        const bool ikwave = (u.pn == 19) && (wc == 0);
        if (ikwave) {
            const f32x4 g00 = *(const f32x4*)(ikv + 8 * fq), g01 = *(const f32x4*)(ikv + 8 * fq + 4), g10 = *(const f32x4*)(ikv + 32 + 8 * fq), g11 = *(const f32x4*)(ikv + 36 + 8 * fq);
            const f32x4 b00 = *(const f32x4*)(ikv + 64 + 8 * fq), b01 = *(const f32x4*)(ikv + 68 + 8 * fq), b10 = *(const f32x4*)(ikv + 96 + 8 * fq), b11 = *(const f32x4*)(ikv + 100 + 8 * fq);
#pragma unroll
            for (int ai = 0; ai < 2; ++ai)
#pragma unroll
                for (int m = 0; m < 4; ++m) {
                    const int row = u.pm * 256 + ai * 128 + wr * 64 + m * 16 + fr;
                    f32x4 a0 = acc[ai][0][m][0], a1 = acc[ai][0][m][1], c0 = acc[ai][1][m][0], c1 = acc[ai][1][m][1];
                    float sm = ((a0.x + a0.y) + (a0.z + a0.w)) + ((a1.x + a1.y) + (a1.z + a1.w)) + ((c0.x + c0.y) + (c0.z + c0.w)) + ((c1.x + c1.y) + (c1.z + c1.w));
                    sm += __shfl_xor(sm, 16); sm += __shfl_xor(sm, 32);
                    const float mean = sm * (1.f / 64.f);
                    a0 = a0 - mean; a1 = a1 - mean; c0 = c0 - mean; c1 = c1 - mean;
                    float sq = ((a0.x * a0.x + a0.y * a0.y) + (a0.z * a0.z + a0.w * a0.w)) + ((a1.x * a1.x + a1.y * a1.y) + (a1.z * a1.z + a1.w * a1.w))
                             + ((c0.x * c0.x + c0.y * c0.y) + (c0.z * c0.z + c0.w * c0.w)) + ((c1.x * c1.x + c1.y * c1.y) + (c1.z * c1.z + c1.w * c1.w));
                    sq += __shfl_xor(sq, 16); sq += __shfl_xor(sq, 32);
                    const float rstd = 1.f / sqrtf(sq * (1.f / 64.f) + EPS);
                    a0 = a0 * rstd * g00 + b00; a1 = a1 * rstd * g01 + b01; c0 = c0 * rstd * g10 + b10; c1 = c1 * rstd * g11 + b11;
                    const f32x4 cs = *(const f32x4*)(tab + (size_t)row * TABW + T_CI + 4 * (fq & 1)), sn = *(const f32x4*)(tab + (size_t)row * TABW + T_SI + 4 * (fq & 1));
                    const f32x4 r0 = a0 * cs - a1 * sn, r1 = a1 * cs + a0 * sn;
                    if (fq < 2) { a0 = r0; a1 = r1; }
                    u32x4 w; w.x = pk_f16(a0.x, a0.y); w.y = pk_f16(a0.z, a0.w); w.z = pk_f16(a1.x, a1.y); w.w = pk_f16(a1.z, a1.w);
                    *(u32x4*)(P + (size_t)row * NV + V_IK_LO + 8 * fq) = w;
                    w.x = pk_f16(c0.x, c0.y); w.y = pk_f16(c0.z, c0.w); w.z = pk_f16(c1.x, c1.y); w.w = pk_f16(c1.z, c1.w);
                    *(u32x4*)(P + (size_t)row * NV + V_IK_HI + 8 * fq) = w;
                }
            return;
        }
#pragma unroll
        for (int bj = 0; bj < 2; ++bj) {
            const int g32 = u.pn * 8 + bj * 4 + wc;
            int kind = 0, toc = 0, tos = 0, gi = 0;
            if (g32 < 64) { if ((g32 & 3) == 0) { kind = 1; toc = T_CA; tos = T_SA; } }
            else if (g32 < 96) { }
            else if (g32 < 128) { if ((g32 & 1) == 0) { kind = 2; toc = T_CI; tos = T_SI; } }
            else if (g32 < 144) { kind = 3; gi = g32 - 128; }
            else if (g32 < 152) { kind = 4; gi = g32 - 144; }
            else if (g32 == 154) { kind = 1; toc = T_CR; tos = T_SR; }
            else if (g32 == 155) { kind = 1; toc = T_CR + 16; tos = T_SR + 16; }
#pragma unroll
            for (int ai = 0; ai < 2; ++ai)
#pragma unroll
                for (int m = 0; m < 4; ++m) {
                    const int row = u.pm * 256 + ai * 128 + wr * 64 + m * 16 + fr;
                    f32x4 v0 = acc[ai][bj][m][0], v1 = acc[ai][bj][m][1];
                    if (kind == 1 || kind == 2) {
                        const int fqq = (kind == 2) ? (fq & 1) : fq;
                        const f32x4 c = *(const f32x4*)(tab + (size_t)row * TABW + toc + 4 * fqq), sn = *(const f32x4*)(tab + (size_t)row * TABW + tos + 4 * fqq);
                        const f32x4 r0 = v0 * c - v1 * sn, r1 = v1 * c + v0 * sn;
                        if (kind == 1 || fq < 2) { v0 = r0; v1 = r1; }
                    } else if (kind == 3 || kind == 4) {
                        float ss = (v0.x * v0.x + v0.y * v0.y) + (v0.z * v0.z + v0.w * v0.w) + (v1.x * v1.x + v1.y * v1.y) + (v1.z * v1.z + v1.w * v1.w);
                        ss += __shfl_xor(ss, 16); ss += __shfl_xor(ss, 32);
                        if (fq == 0) { if (kind == 3) ssq[(size_t)row * 16 + gi] = ss; else sskv[(size_t)row * 8 + gi] = ss; }
                    }
                    u32x4 w; w.x = pk_f16(v0.x, v0.y); w.y = pk_f16(v0.z, v0.w); w.z = pk_f16(v1.x, v1.y); w.w = pk_f16(v1.z, v1.w);
                    *(u32x4*)(P + (size_t)row * NV + u.pn * 256 + bj * 128 + wc * 32 + 8 * fq) = w;
                }
        }
    }
};


DEVINL void p_merge16(Frame& F) {
    const int gw = F.bid * NWAVES + F.wave, NGW = F.G * NWAVES;
    for (int m = gw; m < NT; m += NGW) {
#pragma unroll
        for (int half = 0; half < 2; ++half) {
            const f16* p = F.att16 + (size_t)m * D + half * 1024 + 4 * F.lane;
            f32x4 v[4]; float ss = 0.f;
#pragma unroll
            for (int j = 0; j < 4; ++j) { v[j] = ld4h(p + 256 * j); ss += (v[j].x * v[j].x + v[j].y * v[j].y) + (v[j].z * v[j].z + v[j].w * v[j].w); }
            const float r = 1.f / sqrtf(wave_sum(ss) * (1.f / 1024.f) + EPS);
#if OUTPROJ_F8
            unsigned* o = (unsigned*)((unsigned char*)F.mrgh + (size_t)m * D + half * 1024) + F.lane;
#pragma unroll
            for (int j = 0; j < 4; ++j) { const f32x4 y = v[j] * r; o[64 * j] = pk4_fp8(y.x, y.y, y.z, y.w); }
#else
            u32x2* o = (u32x2*)(F.mrgh + (size_t)m * D + half * 1024) + F.lane;
#pragma unroll
            for (int j = 0; j < 4; ++j) { const f32x4 y = v[j] * r; o[64 * j] = (u32x2){pk_f16(y.x, y.y), pk_f16(y.z, y.w)}; }
#endif
        }
    }
}
struct EpiPre16 {
    static constexpr bool PERM = true;
    f16* C; const float* x; const float* ada; float ascale;
    DEVINL void operator()(const f32x4 (&acc)[2][2][4][2], const g16::Unit& u, int wr, int wc, int fr, int fq) const {
        const int row0 = u.pm * 256 + wr * 64 + fr, col0 = u.pn * 256 + wc * 32 + 8 * fq;
        const float* g1 = ada + (size_t)((u.pm * 256) / S) * 6 * D + 2 * D;
        f32x4 gv[2][2];
#pragma unroll
        for (int bj = 0; bj < 2; ++bj)
#pragma unroll
            for (int n = 0; n < 2; ++n) gv[bj][n] = *(const f32x4*)(g1 + col0 + bj * 128 + n * 4) * ascale;
#pragma unroll
        for (int ai = 0; ai < 2; ++ai)
#pragma unroll
            for (int m = 0; m < 4; ++m) { const size_t ro = (size_t)(row0 + ai * 128 + m * 16) * D + col0;
#pragma unroll
                for (int bj = 0; bj < 2; ++bj) {
                    const f32x4 a = *(const f32x4*)(x + ro + bj * 128) * ALPHA + gv[bj][0] * acc[ai][bj][m][0], b = *(const f32x4*)(x + ro + bj * 128 + 4) * ALPHA + gv[bj][1] * acc[ai][bj][m][1];
                    u32x4 w; w.x = pk_f16(a.x, a.y); w.y = pk_f16(a.z, a.w); w.z = pk_f16(b.x, b.y); w.w = pk_f16(b.z, b.w);
                    *(u32x4*)(C + ro + bj * 128) = w; } }
    }
};
struct MoeLds { int cnt[NE], P[NE], cum[NE + 1], pbase[NE + 1]; };
DEVINL void moe_lds_build(Frame& F, LAS MoeLds* T) {
    __syncthreads();
    if (F.tid == 0) {
        int cu = 0;
        for (int e = 0; e < NE; ++e) { const int c = (int)__hip_atomic_load(F.ctl + CW_CNT + e, __ATOMIC_RELAXED, __HIP_MEMORY_SCOPE_AGENT); const int p = (c + 255) >> 8; T->cnt[e] = c; T->P[e] = p; T->cum[e] = cu; T->pbase[e] = cu; cu += p; }
        T->cum[NE] = cu; T->pbase[NE] = cu;
    }
    __syncthreads();
}
template <int CTX, bool GA_ = (CTX == 2)>
struct MoeOrder {
    static constexpr bool GATHER = GA_;
    const LAS MoeLds* T; const int* list; int x, j, nj;
    DEVINL bool next(int i, g16::Unit& u) const {
        const int li = j + i * nj;
        if (li >= CTX * T->cum[NE]) return false;
        int e = 0;
#pragma unroll 1
        while (e < NE - 1 && li >= CTX * T->cum[e + 1]) ++e;
        const int rem = li - CTX * T->cum[e], P = T->P[e], ctl = rem / P, p = rem - ctl * P, ct = x + 8 * ctl;
        u.pm = T->pbase[e] + p; u.pn = e * (8 * CTX) + ct; u.aux = e + 32 * p; return true;
    }
    DEVINL int arow(const g16::Unit& u, int r) const {
        const int e = u.aux & 31, p = u.aux >> 5, c = T->cnt[e]; int rr = p * 256 + r; rr = rr < c ? rr : c - 1;
        return list[(size_t)e * LISTCAP + rr] >> 2;
    }
};
struct EpiGU8 {
    static constexpr bool PERM = true;
    unsigned char* act; const float* bguP; int probe;
    DEVINL void operator()(const f32x4 (&acc)[2][2][4][2], const g16::Unit& u, int wr, int wc, int fr, int fq) const {
        if (probe) { asm volatile("" :: "v"(acc[0][0][0][0]), "v"(acc[1][1][3][1])); return; }
        const int e = u.aux & 31, ct = u.pn & 15;
        const float* bp = bguP + (size_t)e * 2 * DFF + ct * 256 + wc * 32 + 8 * fq;
        const f32x4 bg0 = *(const f32x4*)(bp), bg1 = *(const f32x4*)(bp + 4), bu0 = *(const f32x4*)(bp + 128), bu1 = *(const f32x4*)(bp + 132);
#pragma unroll
        for (int ai = 0; ai < 2; ++ai)
#pragma unroll
            for (int m = 0; m < 4; ++m) {
                const size_t row = (size_t)u.pm * 256 + ai * 128 + wr * 64 + m * 16 + fr;
                float o[8];
#pragma unroll
                for (int n = 0; n < 2; ++n) {
                    const f32x4 gq = acc[ai][0][m][n] * W8_INV + (n ? bg1 : bg0), uq = acc[ai][1][m][n] * W8_INV + (n ? bu1 : bu0);
#pragma unroll
                    for (int j = 0; j < 4; ++j) { const float g = fminf(gq[j], 7.0f), uu = fminf(fmaxf(uq[j], -7.0f), 7.0f); o[4 * n + j] = (uu + 1.f) * (g * __builtin_amdgcn_rcpf(1.f + __builtin_amdgcn_exp2f(-1.702f * 1.4426950408889634f * g))); }
                }
                const u32x2 w = {pk4_fp8(o[0], o[1], o[2], o[3]), pk4_fp8(o[4], o[5], o[6], o[7])};
                *(u32x2*)(act + row * DFF + ct * 128 + wc * 32 + 8 * fq) = w;
            }
    }
};
struct EpiGU16 {
    static constexpr bool PERM = true;
    f16* act; const float* bguP;
    DEVINL void operator()(const f32x4 (&acc)[2][2][4][2], const g16::Unit& u, int wr, int wc, int fr, int fq) const {
        const int e = u.aux & 31, ct = u.pn & 15;
        const float* bp = bguP + (size_t)e * 2 * DFF + ct * 256 + wc * 32 + 8 * fq;
        const f32x4 bg0 = *(const f32x4*)(bp), bg1 = *(const f32x4*)(bp + 4), bu0 = *(const f32x4*)(bp + 128), bu1 = *(const f32x4*)(bp + 132);
#pragma unroll
        for (int ai = 0; ai < 2; ++ai)
#pragma unroll
            for (int m = 0; m < 4; ++m) {
                const size_t row = (size_t)u.pm * 256 + ai * 128 + wr * 64 + m * 16 + fr;
                float o[8];
#pragma unroll
                for (int n = 0; n < 2; ++n) {
                    const f32x4 gq = acc[ai][0][m][n] + (n ? bg1 : bg0), uq = acc[ai][1][m][n] + (n ? bu1 : bu0);
#pragma unroll
                    for (int j = 0; j < 4; ++j) { const float g = fminf(gq[j], 7.0f), uu = fminf(fmaxf(uq[j], -7.0f), 7.0f); o[4 * n + j] = (uu + 1.f) * (g / (1.f + __expf(-1.702f * g))); }
                }
                u32x4 w; w.x = pk_f16(o[0], o[1]); w.y = pk_f16(o[2], o[3]); w.z = pk_f16(o[4], o[5]); w.w = pk_f16(o[6], o[7]);
                *(u32x4*)(act + row * DFF + ct * 128 + wc * 32 + 8 * fq) = w;
            }
    }
};
struct EpiDown16 {
    static constexpr bool PERM = true;
    f16* y; const float* b_dn; const int* list; const float* gate; const LAS MoeLds* T; float ascale;
    DEVINL void operator()(const f32x4 (&acc)[2][2][4][2], const g16::Unit& u, int wr, int wc, int fr, int fq) const {
        const int e = u.aux & 31, p = u.aux >> 5, ct = u.pn & 7, cnt = T->cnt[e];
        const float* bp = b_dn + (size_t)e * D + ct * 256 + wc * 32 + 8 * fq;
        f32x4 bv[2][2];
#pragma unroll
        for (int bj = 0; bj < 2; ++bj) { bv[bj][0] = *(const f32x4*)(bp + bj * 128); bv[bj][1] = *(const f32x4*)(bp + bj * 128 + 4); }
#pragma unroll
        for (int ai = 0; ai < 2; ++ai)
#pragma unroll
            for (int m = 0; m < 4; ++m) {
                const int rr = p * 256 + ai * 128 + wr * 64 + m * 16 + fr;
                if (rr < cnt) {
                    const int aid = list[(size_t)e * LISTCAP + rr]; const float gt = gate[aid];
#pragma unroll
                    for (int bj = 0; bj < 2; ++bj) {
                        const f32x4 a = (acc[ai][bj][m][0] * ascale + bv[bj][0]) * gt, b = (acc[ai][bj][m][1] * ascale + bv[bj][1]) * gt;
                        *(u32x2*)((unsigned char*)y + (size_t)aid * D + ct * 256 + bj * 128 + wc * 32 + 8 * fq) = (u32x2){pk4_fp8(a.x, a.y, a.z, a.w), pk4_fp8(b.x, b.y, b.z, b.w)};
                    }
                }
            }
    }
};
DEVINL f32x4 ld4q(const unsigned char* p) { const unsigned w = *(const unsigned*)p; const auto lo = __builtin_amdgcn_cvt_pk_f32_fp8(w, false), hi = __builtin_amdgcn_cvt_pk_f32_fp8(w, true); return (f32x4){lo[0], lo[1], hi[0], hi[1]}; }
DEVINL void p_final16(Frame& F) {
    const int gw = F.bid * NWAVES + F.wave, NGW = F.G * NWAVES, lane = F.lane;
    for (int m = gw; m < NT; m += NGW) {
        const int b = m / S;
        const f16* xr = (const f16*)F.x1 + (size_t)m * D + 4 * lane;
        const f32x4* g2 = (const f32x4*)(F.ada + (size_t)b * 6 * D + 5 * D) + lane;
        const unsigned char* y0 = (const unsigned char*)F.y16 + (size_t)m * 4 * D + 4 * lane;
        f32x4 v[8]; float s = 0.f;
#pragma unroll
        for (int j = 0; j < 8; ++j) {
            const f32x4 ys = ((ld4q(y0 + 256 * j) + ld4q(y0 + D + 256 * j)) + ld4q(y0 + 2 * D + 256 * j)) + ld4q(y0 + 3 * D + 256 * j);
            v[j] = ld4h(xr + 256 * j) * ALPHA + g2[64 * j] * ys; s += (v[j].x + v[j].y) + (v[j].z + v[j].w);
        }
        const float mean = wave_sum(s) * (1.f / D); float s2 = 0.f;
#pragma unroll
        for (int j = 0; j < 8; ++j) { v[j] = v[j] - mean; s2 += (v[j].x * v[j].x + v[j].y * v[j].y) + (v[j].z * v[j].z + v[j].w * v[j].w); }
        const float rstd = 1.f / sqrtf(wave_sum(s2) * (1.f / D) + EPS);
        const f32x4* g = (const f32x4*)F.lnfg + lane; const f32x4* bb = (const f32x4*)F.lnfb + lane;
        f32x4* o = (f32x4*)(F.out + (size_t)m * D) + lane;
#pragma unroll
        for (int j = 0; j < 8; ++j) o[64 * j] = v[j] * rstd * g[64 * j] + bb[64 * j];
    }
}

DEVINL float row_rstd(const float* ss, int n, float inv_n) { float a = 0.f; for (int i = 0; i < n; i += 4) { const f32x4 v = *(const f32x4*)(ss + i); a += (v.x + v.y) + (v.z + v.w); } return 1.f / sqrtf(a * inv_n + EPS); }
struct EpiQup {
    static constexpr bool PERM = true;
    f16* Q; const float* tab; const float* ssq;
    DEVINL void operator()(const f32x4 (&acc)[2][2][4][2], const g16::Unit& u, int wr, int wc, int fr, int fq) const {
#pragma unroll
        for (int ai = 0; ai < 2; ++ai)
#pragma unroll
            for (int m = 0; m < 4; ++m) {
                const int row = u.pm * 256 + ai * 128 + wr * 64 + m * 16 + fr;
                const float rs = row_rstd(ssq + (size_t)row * 16, 16, 1.f / 512.f);
#pragma unroll
                for (int bj = 0; bj < 2; ++bj) {
                    const int g32 = u.pn * 8 + bj * 4 + wc, hg = g32 % 6;
                    f32x4 v0 = acc[ai][bj][m][0] * rs, v1 = acc[ai][bj][m][1] * rs;
                    if (hg >= 4) {
                        const int to = (hg == 5) ? 16 : 0;
                        const f32x4 c = *(const f32x4*)(tab + (size_t)row * TABW + T_CR + to + 4 * fq), sn = *(const f32x4*)(tab + (size_t)row * TABW + T_SR + to + 4 * fq);
                        const f32x4 r0 = v0 * c - v1 * sn, r1 = v1 * c + v0 * sn; v0 = r0; v1 = r1;
                    }
                    u32x4 w; w.x = pk_f16(v0.x, v0.y); w.y = pk_f16(v0.z, v0.w); w.z = pk_f16(v1.x, v1.y); w.w = pk_f16(v1.z, v1.w);
                    *(u32x4*)(Q + (size_t)row * 1536 + u.pn * 256 + bj * 128 + wc * 32 + 8 * fq) = w;
                }
            }
    }
};
struct EpiKVup {
    static constexpr bool PERM = true;
    f16* KV; const float* sskv;
    DEVINL void operator()(const f32x4 (&acc)[2][2][4][2], const g16::Unit& u, int wr, int wc, int fr, int fq) const {
#pragma unroll
        for (int ai = 0; ai < 2; ++ai)
#pragma unroll
            for (int m = 0; m < 4; ++m) {
                const int row = u.pm * 256 + ai * 128 + wr * 64 + m * 16 + fr;
                const float rs = row_rstd(sskv + (size_t)row * 8, 8, 1.f / 256.f);
#pragma unroll
                for (int bj = 0; bj < 2; ++bj) {
                    const f32x4 v0 = acc[ai][bj][m][0] * rs, v1 = acc[ai][bj][m][1] * rs;
                    u32x4 w; w.x = pk_f16(v0.x, v0.y); w.y = pk_f16(v0.z, v0.w); w.z = pk_f16(v1.x, v1.y); w.w = pk_f16(v1.z, v1.w);
                    *(u32x4*)(KV + (size_t)row * D + u.pn * 256 + bj * 128 + wc * 32 + 8 * fq) = w;
                }
            }
    }
};

typedef short s16x4 __attribute__((ext_vector_type(4)));
DEVINL f16x4 tr_read(const LAS unsigned char* p) { return __builtin_bit_cast(f16x4, __builtin_amdgcn_ds_read_tr16_b64_v4i16((LAS s16x4*)p)); }
constexpr int AT_K1 = 0, AT_V = 16384, AT_K2 = 32768, AT_BUF = 40960;
template <bool MLA>
DEVINL void attn_unit16(LAS unsigned char* lds, const f16* Q1, const f16* Q2, int ldq, const f16* K1, int ldk1, const f16* K2, int ldk2, const f16* V, int ldv,
                        const u64* mask, f16* O, int ldo, int qb, float c2, int probe = 0) {
    constexpr int NS1 = 8, NS2 = MLA ? 4 : 0;
    int tid_ = threadIdx.x; asm volatile("" : "+v"(tid_));
    const int tid = tid_, lane = tid & 63, wid = __builtin_amdgcn_readfirstlane(tid >> 6), ql = lane & 31, hi = lane >> 5;
    const int qrow = wid * 32 + ql;
    const int mytiles = 4 * qb + (wid >> 1) + 1, nt = 4 * qb + 4;
    f16x8 qf[NS1 + NS2];
#pragma unroll
    for (int s2 = 0; s2 < NS1; ++s2) qf[s2] = *(const f16x8*)(Q1 + (size_t)qrow * ldq + 16 * s2 + 8 * hi);
    if constexpr (MLA) {
#pragma unroll
        for (int s2 = 0; s2 < NS2; ++s2) qf[NS1 + s2] = *(const f16x8*)(Q2 + (size_t)qrow * ldq + 16 * s2 + 8 * hi);
    }
    const int sr0 = tid >> 4, sc0 = tid & 15, sr2 = tid >> 3, sc2 = tid & 7;
    const unsigned gk1 = (unsigned)((sc0 ^ (sr0 & 15)) * 8), gv = (unsigned)((sc0 ^ (((sr0 & 3) << 2) | ((sr0 >> 2) & 3))) * 8), gk2 = (unsigned)((sc2 ^ (sr2 & 7)) * 8);
    const unsigned dsw = (unsigned)wid * 1024u;
    const unsigned ldsbase = (unsigned)(size_t)lds;
    const int mrow = (wid & 3) * 64 + lane;
#define AT_DMA(gp, off) do { unsigned keep_; const unsigned dst_ = (unsigned)__builtin_amdgcn_readfirstlane((int)(ldsbase + (unsigned)(off))); \
        asm volatile("s_mov_b32 %0, m0\n\ts_mov_b32 m0, %2\n\ts_nop 0\n\tglobal_load_lds_dwordx4 %1, off\n\ts_mov_b32 m0, %0" : "=&s"(keep_) : "v"((const void*)(gp)), "s"(dst_) : "memory"); } while (0)
#define AT_STAGE(t, b) do { const size_t kr = (size_t)(t) * 64 + sr0; LAS unsigned char* bp_ = lds + (b) * AT_BUF + dsw; \
        AT_DMA(K1 + kr * ldk1 + gk1, (b) * AT_BUF + AT_K1 + dsw); AT_DMA(K1 + (kr + 32) * ldk1 + gk1, (b) * AT_BUF + AT_K1 + 8192 + dsw); \
        AT_DMA(V + kr * ldv + gv, (b) * AT_BUF + AT_V + dsw); AT_DMA(V + (kr + 32) * ldv + gv, (b) * AT_BUF + AT_V + 8192 + dsw); \
        if constexpr (MLA) AT_DMA(K2 + ((size_t)(t) * 64 + sr2) * ldk2 + gk2, (b) * AT_BUF + AT_K2 + dsw); \
        else AT_DMA((const char*)mask + ((size_t)mrow * 64 + (size_t)(2 * ((t) >> 1))) * 8, (b) * AT_BUF + AT_K2 + dsw); (void)bp_; } while (0)
    const unsigned ka = (unsigned)(ql * 256) | (unsigned)((hi ^ (ql & 15)) << 4);
    const unsigned ka2 = (unsigned)(ql * 128) | (unsigned)((hi ^ (ql & 7)) << 4);
    const int tq = (lane & 15) >> 2, tp = lane & 3, gb = (lane >> 4) & 1;
    unsigned vb[2];
#pragma unroll
    for (int half = 0; half < 2; ++half) {
        const int row = 8 * half + 4 * hi + tq, low = (2 * gb + (tp >> 1)) ^ ((row >> 2) & 3);
        vb[half] = (unsigned)(row * 256 + (low << 4) + 8 * (tp & 1));
    }
    f32x16 o[4];
#pragma unroll
    for (int dt = 0; dt < 4; ++dt)
#pragma unroll
        for (int r = 0; r < 16; ++r) o[dt][r] = 0.f;
    float m_run = -1e30f, l_run = 0.f;
    __syncthreads();
    AT_STAGE(0, 0); AT_STAGE(1, 1);
#pragma unroll
    for (int s2 = 0; s2 < NS1 + NS2; ++s2) {
#pragma unroll
        for (int j = 0; j < 8; ++j) qf[s2][j] = (f16)((float)qf[s2][j] * c2);
        asm volatile("" : "+v"(qf[s2])); }
    asm volatile("s_waitcnt vmcnt(5)" ::: "memory");
    __builtin_amdgcn_s_barrier();
    int slot = 0;
    for (int t = 0; t < (probe == 8 ? 0 : nt); ++t) {
        { const int s2n = slot + 2 >= 3 ? slot - 1 : slot + 2; if (t + 2 < nt && probe != 5 && probe != 7) AT_STAGE(t + 2, s2n); }
        if (t < mytiles) {
            const LAS unsigned char* bp = lds + slot * AT_BUF;
            f32x16 st[2];
            __builtin_amdgcn_s_setprio(1);
#pragma unroll
            for (int kb = 0; kb < 2; ++kb)
#pragma unroll
                for (int r = 0; r < 16; ++r) st[kb][r] = 0.f;
            if (probe != 4 && probe < 6) {
                f16x8 kf[2][NS1];
#pragma unroll
                for (int s2 = 0; s2 < NS1; ++s2)
#pragma unroll
                    for (int kb = 0; kb < 2; ++kb) kf[kb][s2] = *(const LAS f16x8*)(bp + AT_K1 + kb * 8192 + (ka ^ (unsigned)(32 * s2)));
                __builtin_amdgcn_sched_barrier(0);
#pragma unroll
                for (int s2 = 0; s2 < NS1; ++s2)
#pragma unroll
                    for (int kb = 0; kb < 2; ++kb) st[kb] = __builtin_amdgcn_mfma_f32_32x32x16_f16(kf[kb][s2], qf[s2], st[kb], 0, 0, 0);
            }
            if (MLA && probe != 4 && probe < 6) {
                f16x8 kf2[2][NS2 > 0 ? NS2 : 1];
#pragma unroll
                for (int s2 = 0; s2 < NS2; ++s2)
#pragma unroll
                    for (int kb = 0; kb < 2; ++kb) kf2[kb][s2] = *(const LAS f16x8*)(bp + AT_K2 + kb * 4096 + (ka2 ^ (unsigned)(32 * s2)));
                __builtin_amdgcn_sched_barrier(0);
#pragma unroll
                for (int s2 = 0; s2 < NS2; ++s2)
#pragma unroll
                    for (int kb = 0; kb < 2; ++kb) st[kb] = __builtin_amdgcn_mfma_f32_32x32x16_f16(kf2[kb][s2], qf[NS1 + s2], st[kb], 0, 0, 0);
            }
            __builtin_amdgcn_s_setprio(0);
            if (probe != 2 && probe < 6) {
            u64 mw = ~0ull;
            if constexpr (!MLA) mw = *(const LAS u64*)(bp + AT_K2 + qrow * 16 + (t & 1) * 8) >> (4 * hi);
            float mx = -INFINITY;
#pragma unroll
            for (int kb = 0; kb < 2; ++kb)
#pragma unroll
                for (int r = 0; r < 16; ++r) { const int bit = 32 * kb + (r & 3) + 8 * (r >> 2); const float x = ((mw >> bit) & 1ull) ? st[kb][r] : -INFINITY; st[kb][r] = x; mx = fmaxf(mx, x); }
            mx = fmaxf(mx, __shfl_xor(mx, 32));
            const float mn = fmaxf(m_run, mx), alpha = __builtin_amdgcn_exp2f(m_run - mn);
            float ps = 0.f;
#pragma unroll
            for (int kb = 0; kb < 2; ++kb)
#pragma unroll
                for (int r = 0; r < 16; ++r) { const float p = __builtin_amdgcn_exp2f(st[kb][r] - mn); st[kb][r] = p; ps += p; }
            ps += __shfl_xor(ps, 32);
            const float m_old = m_run;
            l_run = l_run * alpha + ps; m_run = mn;
            if (!__all(mn == m_old)) {
#pragma unroll
                for (int dt = 0; dt < 4; ++dt)
#pragma unroll
                    for (int r = 0; r < 16; ++r) o[dt][r] *= alpha;
            }
            }
            __builtin_amdgcn_s_setprio(1);
            if (probe != 3 && probe < 6)
#pragma unroll
            for (int kb = 0; kb < 2; ++kb)
#pragma unroll
                for (int s2 = 0; s2 < 2; ++s2) {
                    f16x8 pf;
#pragma unroll
                    for (int j = 0; j < 8; ++j) pf[j] = (f16)st[kb][8 * s2 + j];
#pragma unroll
                    for (int dt = 0; dt < 4; ++dt) {
                        const unsigned dsw = (unsigned)((dt ^ tq) << 6);
                        const f16x4 x0 = tr_read(bp + AT_V + (32 * kb + 16 * s2) * 256 + (vb[0] + dsw)), x1 = tr_read(bp + AT_V + (32 * kb + 16 * s2) * 256 + (vb[1] + dsw));
                        const f16x8 a = {x0[0], x0[1], x0[2], x0[3], x1[0], x1[1], x1[2], x1[3]};
                        o[dt] = __builtin_amdgcn_mfma_f32_32x32x16_f16(a, pf, o[dt], 0, 0, 0);
                    }
                }
        }
        __builtin_amdgcn_s_setprio(0);
        if (t + 2 < nt) asm volatile("s_waitcnt vmcnt(5)" ::: "memory");
        else asm volatile("s_waitcnt vmcnt(0)" ::: "memory");
        asm volatile("s_waitcnt lgkmcnt(0)" ::: "memory");
        __builtin_amdgcn_s_barrier();
        slot = slot + 1 >= 3 ? 0 : slot + 1;
    }
    if (probe) { asm volatile("" :: "v"(o[0]), "v"(o[1]), "v"(o[2]), "v"(o[3]), "v"(l_run)); return; }
    const float inv = 1.f / l_run;
#pragma unroll
    for (int dt = 0; dt < 4; ++dt)
#pragma unroll
        for (int g = 0; g < 4; ++g) {
            const u32x2 w = {pk_f16(o[dt][4 * g] * inv, o[dt][4 * g + 1] * inv), pk_f16(o[dt][4 * g + 2] * inv, o[dt][4 * g + 3] * inv)};
            *(u32x2*)(O + (size_t)qrow * ldo + 32 * dt + 8 * g + 4 * hi) = w;
        }
#undef AT_DMA
#undef AT_STAGE
}
DEVINL void p_attn16(Frame& F, LAS unsigned char* lds, int probe = 0) {
    for (int p = F.bid; p < 512; p += F.G) {
        const int kind = p >> 8, bh = (p & 7) * 4 + ((p >> 6) & 3), b = bh >> 3, hd = bh & 7, x = (p >> 3) & 7;
#pragma unroll 1
        for (int half = 0; half < 2; ++half) {
            const int qb = half ? x : 15 - x;
            const size_t t0 = (size_t)b * S + (size_t)qb * 256, tb = (size_t)b * S;
            if (kind == 0)
                attn_unit16<false>(lds, F.projh + t0 * NV + V_AQ + hd * 128, nullptr, NV, F.projh + tb * NV + V_AK + hd * 128, NV, nullptr, 0, F.projh + tb * NV + V_AV + hd * 128, NV,
                                   F.mask + t0 * 64, F.att16 + t0 * D + hd * 128, D, qb, 0.08838834764831845f * 1.4426950408889634f, probe);
            else
                attn_unit16<true>(lds, F.qb16 + t0 * 1536 + hd * 192, F.qb16 + t0 * 1536 + hd * 192 + 128, 1536, F.kv16 + tb * D + hd * 256, D, F.projh + tb * NV + V_KR, NV, F.kv16 + tb * D + hd * 256 + 128, D,
                                  nullptr, F.att16 + t0 * D + 1024 + hd * 128, D, qb, 0.07216878364870322f * 1.4426950408889634f, probe);
        }
    }
}

DEVINL void p_tokpost(Frame& F) {
    const int gw = F.bid * NWAVES + F.wave, NGW = F.G * NWAVES, lane = F.lane;
    for (int m = gw; m < NT; m += NGW) {
        float sq = 0.f, skv = 0.f;
        if (lane < 16) sq = F.ssq[(size_t)m * 16 + lane];
        if (lane < 8) skv = F.sskv[(size_t)m * 8 + lane];
        const float rq = 1.f / sqrtf(wave_sum(sq) * (1.f / 512.f) + EPS), rkv = 1.f / sqrtf(wave_sum(skv) * (1.f / 256.f) + EPS);
        if (lane == 0) { F.rq[m] = rq; F.rkv[m] = rkv; }
        f16* pk = F.projh + (size_t)m * NV + (lane < 32 ? V_IK_LO + permI(lane) : V_IK_HI + (lane - 32));
        const float v = (float)*pk;
        const float mean = wave_sum(v) * (1.f / 64.f);
        const float d = v - mean;
        const float var = wave_sum(d * d) * (1.f / 64.f);
        float y = d * (1.f / sqrtf(var + EPS)) * F.ikg[lane] + F.ikb[lane];
        const float other = __shfl_xor(y, 8);
        const float c = F.tab[(size_t)m * TABW + T_CI + (lane & 7)], sn = F.tab[(size_t)m * TABW + T_SI + (lane & 7)];
        if (lane < 8) y = y * c - other * sn; else if (lane < 16) y = y * c + other * sn;
        *pk = (f16)y;
    }
}
DEVINL float relu_i(float x) { const int i = __builtin_bit_cast(int, x); return __builtin_bit_cast(float, i > 0 ? i : 0); }
DEVINL void p_index16(Frame& F, LAS unsigned char* lds, int probe = 0) {
    int tid_ = threadIdx.x; asm volatile("" : "+v"(tid_));
    const int tid = tid_, lane = tid & 63, wid = __builtin_amdgcn_readfirstlane(tid >> 6), ql = lane & 31, hi = lane >> 5;
    for (int u = F.bid; u < NT / 32; u += F.G) {
        const int rnd = u / F.G, c0 = u - rnd * F.G, j = (rnd & 1) ? (NT / 32 - 1 - c0 - (rnd >> 1) * F.G) : (c0 + (rnd >> 1) * F.G);
        const int ci = 63 - (j >> 3), b = (j >> 1) & 3, t0 = b * S + ci * 64 + (j & 1) * 32;
        __syncthreads();
#pragma unroll
        for (int it = 0; it < 8; ++it) {
            const int p = it * 8192 + tid * 16, q = p >> 11, pc = (p & 2047) >> 4, sc = pc ^ (q & 15);
            __builtin_amdgcn_global_load_lds((const unsigned*)(F.projh + (size_t)(t0 + q) * NV + V_IQ + sc * 8), (LAS unsigned*)(lds + it * 8192 + wid * 1024), 16, 0, 0);
        }
        LAS float* wl = (LAS float*)(lds + 65536);
        if (tid < 512) { const int q = tid >> 4, h = tid & 15; wl[q * 17 + h] = (float)F.projh[(size_t)(t0 + q) * NV + V_IW + h] * INDEX_SCALE; }
        __syncthreads();
        const unsigned qbase = (unsigned)(ql * 2048);
        f16x8 kn[2][4];
        {   const int kt0 = wid <= ci ? wid : ci;
#pragma unroll
            for (int kb = 0; kb < 2; ++kb)
#pragma unroll
                for (int s2 = 0; s2 < 4; ++s2) kn[kb][s2] = *(const f16x8*)(F.projh + ((size_t)b * S + kt0 * 64 + kb * 32 + ql) * NV + (s2 < 2 ? V_IK_LO + 16 * s2 : V_IK_HI + 16 * (s2 - 2)) + 8 * hi); }
        for (int kt = wid; kt <= ci; kt += NWAVES) {
            f16x8 ka[2][4];
#pragma unroll
            for (int kb = 0; kb < 2; ++kb)
#pragma unroll
                for (int s2 = 0; s2 < 4; ++s2) ka[kb][s2] = kn[kb][s2];
            {   const int ktn = kt + NWAVES <= ci ? kt + NWAVES : kt;
#pragma unroll
                for (int kb = 0; kb < 2; ++kb)
#pragma unroll
                    for (int s2 = 0; s2 < 4; ++s2) kn[kb][s2] = *(const f16x8*)(F.projh + ((size_t)b * S + ktn * 64 + kb * 32 + ql) * NV + (s2 < 2 ? V_IK_LO + 16 * s2 : V_IK_HI + 16 * (s2 - 2)) + 8 * hi); }
            f32x16 sc[2];
#pragma unroll
            for (int kb = 0; kb < 2; ++kb)
#pragma unroll
                for (int r = 0; r < 16; ++r) sc[kb][r] = 0.f;
#pragma unroll 2
            for (int h = 0; h < 16; ++h) {
                const float wh = wl[ql * 17 + h];
                f32x16 d0, d1;
#pragma unroll
                for (int r = 0; r < 16; ++r) { d0[r] = 0.f; d1[r] = 0.f; }
#pragma unroll
                for (int s2 = 0; s2 < 4; ++s2) {
                    const f16x8 qfrag = *(const LAS f16x8*)(lds + qbase + (((unsigned)(8 * h + 2 * s2 + hi) ^ (unsigned)(ql & 15)) << 4));
                    d0 = __builtin_amdgcn_mfma_f32_32x32x16_f16(ka[0][s2], qfrag, d0, 0, 0, 0);
                    d1 = __builtin_amdgcn_mfma_f32_32x32x16_f16(ka[1][s2], qfrag, d1, 0, 0, 0);
                }
#pragma unroll
                for (int r = 0; r < 16; ++r) { sc[0][r] += wh * relu_i(d0[r]); sc[1][r] += wh * relu_i(d1[r]); }
            }
            float* srow = F.score + (size_t)(t0 + ql) * S + kt * 64 + 4 * hi;
            if (probe == 1) { asm volatile("" :: "v"(sc[0]), "v"(sc[1])); continue; }
#pragma unroll
            for (int kb = 0; kb < 2; ++kb)
#pragma unroll
                for (int g4 = 0; g4 < 4; ++g4) *(f32x4*)(srow + kb * 32 + 8 * g4) = (f32x4){sc[kb][4 * g4], sc[kb][4 * g4 + 1], sc[kb][4 * g4 + 2], sc[kb][4 * g4 + 3]};
        }
    }
}
DEVINL int wave_prefix_incl(int x) {
    x += __builtin_amdgcn_update_dpp(0, x, 0x111, 0xf, 0xf, false);
    x += __builtin_amdgcn_update_dpp(0, x, 0x112, 0xf, 0xf, false);
    x += __builtin_amdgcn_update_dpp(0, x, 0x114, 0xf, 0xf, false);
    x += __builtin_amdgcn_update_dpp(0, x, 0x118, 0xf, 0xf, false);
    x += __builtin_amdgcn_update_dpp(0, x, 0x142, 0xa, 0xf, false);
    x += __builtin_amdgcn_update_dpp(0, x, 0x143, 0xc, 0xf, false);
    return x;
}
DEVINL int wave_total(int x) {
    x += __builtin_amdgcn_update_dpp(0, x, 0x111, 0xf, 0xf, false);
    x += __builtin_amdgcn_update_dpp(0, x, 0x112, 0xf, 0xf, false);
    x += __builtin_amdgcn_update_dpp(0, x, 0x114, 0xf, 0xf, false);
    x += __builtin_amdgcn_update_dpp(0, x, 0x118, 0xf, 0xf, false);
    x += __builtin_amdgcn_update_dpp(0, x, 0x142, 0xa, 0xf, false);
    x += __builtin_amdgcn_update_dpp(0, x, 0x143, 0xc, 0xf, false);
    return __builtin_amdgcn_readlane(x, 63);
}
template <int SHIFT, int NBITS>
DEVINL unsigned radix_pass(LAS unsigned* hist, const unsigned (&key)[64], int ci, unsigned hiprefix, int& K, int& cnt, int lane) {
    constexpr int NB = 1 << NBITS, PER = NB / 64;
#pragma unroll
    for (int j = 0; j < PER / 4; ++j) *(LAS u32x4*)(hist + PER * lane + 4 * j) = (u32x4){0u, 0u, 0u, 0u};
    asm volatile("s_waitcnt lgkmcnt(0)" ::: "memory");
#pragma unroll
    for (int g = 0; g < 4; ++g) if (16 * g <= ci) {
#pragma unroll
        for (int i = 16 * g; i < 16 * g + 16; ++i) {
            const unsigned kx = key[i];
            const bool in = (SHIFT + NBITS >= 32) ? (kx != 0u) : ((kx >> ((SHIFT + NBITS) & 31)) == hiprefix);
            if (in) __hip_atomic_fetch_add(hist + ((kx >> SHIFT) & (NB - 1)), 1u, __ATOMIC_RELAXED, __HIP_MEMORY_SCOPE_WORKGROUP);
        }
    }
    asm volatile("s_waitcnt lgkmcnt(0)" ::: "memory");
    unsigned c[PER]; int t = 0;
#pragma unroll
    for (int j = 0; j < PER / 4; ++j) { const u32x4 v = *(const LAS u32x4*)(hist + PER * (63 - lane) + 4 * j); c[4 * j] = v.x; c[4 * j + 1] = v.y; c[4 * j + 2] = v.z; c[4 * j + 3] = v.w; t += (int)(v.x + v.y + v.z + v.w); }
    const int incl = wave_prefix_incl(t);
    const int excl = incl - t;
    const u64 hit = __ballot(excl < K && K <= incl);
    const int ls = __builtin_amdgcn_readfirstlane(__builtin_ctzll(hit));
    const int kp = K - __builtin_amdgcn_readlane(excl, ls);
    int acc = 0, found = -1, above = 0, cf = 0;
#pragma unroll
    for (int j = PER - 1; j >= 0; --j) {
        const int cj = (int)__builtin_amdgcn_readlane(c[j], ls);
        const bool take = (found < 0) && (acc + cj >= kp);
        above = take ? acc : above; cf = take ? cj : cf; found = take ? j : found; acc += cj;
    }
    K = kp - above; cnt = cf;
    return (unsigned)(PER * (63 - ls) + found);
}
DEVINL void p_topk16(Frame& F, LAS unsigned char* lds) {
    const int gw = F.bid * NWAVES + F.wave, NGW = F.G * NWAVES, lane = F.lane;
    LAS unsigned* hist = (LAS unsigned*)(lds + F.wave * 8192);
#define TK_QUERY(qi_, q_, ci_) const int j_##q_ = (qi_) / NGW, base_##q_ = (qi_) % NGW, r_##q_ = (j_##q_ & 1) ? (NT - 1 - (base_##q_ + (j_##q_ >> 1) * NGW)) : (base_##q_ + (j_##q_ >> 1) * NGW); \
        const int q_ = (r_##q_ % 4) * S + (r_##q_ / 4); const int ci_ = __builtin_amdgcn_readfirstlane((q_ % S) >> 6);
#define TK_LOAD(dst_, q_, ci_) do { const float* srow_ = F.score + (size_t)(q_) * S + lane; _Pragma("unroll") for (int g = 0; g < 4; ++g) { if (16 * g <= (ci_) && (ci_) >= 4) { \
        _Pragma("unroll") for (int i = 16 * g; i < 16 * g + 16; ++i) dst_[i] = srow_[64 * i]; } } } while (0)
    float raw[64];
#pragma unroll
    for (int i = 0; i < 64; ++i) raw[i] = 0.f;
    if (gw < NT) { TK_QUERY(gw, q0, c0); TK_LOAD(raw, q0, c0); }
    for (int qi = gw; qi < NT; qi += NGW) {
        TK_QUERY(qi, q, ci);
        u64 myword = ~0ull;
        unsigned key[64];
#pragma unroll
        for (int i = 0; i < 64; ++i) { const unsigned m = ~(unsigned)((ci - i) >> 31); key[i] = f2key(raw[i]) & m; }
        if (qi + NGW < NT) { TK_QUERY(qi + NGW, qn, cn); TK_LOAD(raw, qn, cn); }
        if (ci >= 4) {
            int K = 256, cnt = 0;
            const unsigned bA = radix_pass<21, 11>(hist, key, ci, 0u, K, cnt, lane);
            const unsigned bB = radix_pass<10, 11>(hist, key, ci, bA, K, cnt, lane);
            const unsigned bC = radix_pass<0, 10>(hist, key, ci, (bA << 11) | bB, K, cnt, lane);
            const unsigned T = (bA << 21) | (bB << 10) | bC;
            unsigned wlo = 0u, whi = 0u;
            if (cnt == K) {
#pragma unroll
                for (int i = 0; i < 64; ++i) { const u64 sel = __ballot(key[i] >= T); const bool me = (lane == i); wlo = me ? (unsigned)sel : wlo; whi = me ? (unsigned)(sel >> 32) : whi; }
            } else {
                int need = K;
#pragma unroll 1
                for (int i = 0; i <= ci; ++i) {
                    unsigned kv = 0u;
#pragma unroll
                    for (int jj = 0; jj < 64; ++jj) kv = (i == jj) ? key[jj] : kv;
                    u64 sel = __ballot(kv > T); u64 t2 = __ballot(kv == T);
                    while (t2 && need > 0) { const u64 low = t2 & (0ull - t2); sel |= low; t2 ^= low; --need; }
                    if (lane == i) { wlo = (unsigned)sel; whi = (unsigned)(sel >> 32); }
                }
            }
            myword = ((u64)whi << 32) | wlo;
        }
        if (lane <= ci) F.mask[(size_t)q * 64 + lane] = myword;
    }
#undef TK_QUERY
#undef TK_LOAD
}
typedef float f32x4_t __attribute__((ext_vector_type(4)));
DEVINL void p_router16(Frame& F, LAS unsigned char* lds) {
    int tid_ = threadIdx.x; asm volatile("" : "+v"(tid_));
    const int tid = tid_, lane = tid & 63, wid = __builtin_amdgcn_readfirstlane(tid >> 6);
    LAS float* part = (LAS float*)(lds + 65536);
    for (int tile = F.bid; tile < NT / 16; tile += F.G) {
        __syncthreads();
        {
            f32x4 v[2][8]; float s[2], mean[2], s2[2], rstd[2];
            f16* xr[2];
#pragma unroll
            for (int rr = 0; rr < 2; ++rr) { xr[rr] = (f16*)F.x1 + (size_t)(tile * 16 + wid * 2 + rr) * D + 4 * lane; s[rr] = 0.f;
#pragma unroll
                for (int j = 0; j < 8; ++j) { v[rr][j] = ld4h(xr[rr] + 256 * j); s[rr] += (v[rr][j].x + v[rr][j].y) + (v[rr][j].z + v[rr][j].w); } }
#pragma unroll
            for (int rr = 0; rr < 2; ++rr) { mean[rr] = wave_sum(s[rr]) * (1.f / D); s2[rr] = 0.f;
#pragma unroll
                for (int j = 0; j < 8; ++j) { v[rr][j] = v[rr][j] - mean[rr]; s2[rr] += (v[rr][j].x * v[rr][j].x + v[rr][j].y * v[rr][j].y) + (v[rr][j].z * v[rr][j].z + v[rr][j].w * v[rr][j].w); } }
            const f32x4* g = (const f32x4*)F.lnmg + lane; const f32x4* bb = (const f32x4*)F.lnmb + lane;
#pragma unroll
            for (int rr = 0; rr < 2; ++rr) { rstd[rr] = 1.f / sqrtf(wave_sum(s2[rr]) * (1.f / D) + EPS); s[rr] = 0.f; }
#pragma unroll
            for (int j = 0; j < 8; ++j) { const f32x4 gj = g[64 * j], bj = bb[64 * j];
#pragma unroll
                for (int rr = 0; rr < 2; ++rr) { v[rr][j] = v[rr][j] * rstd[rr] * gj + bj; *(u32x2*)(xr[rr] + 256 * j) = (u32x2){pk_f16(v[rr][j].x, v[rr][j].y), pk_f16(v[rr][j].z, v[rr][j].w)}; s[rr] += (v[rr][j].x + v[rr][j].y) + (v[rr][j].z + v[rr][j].w); } }
#pragma unroll
            for (int rr = 0; rr < 2; ++rr) { mean[rr] = wave_sum(s[rr]) * (1.f / D); s2[rr] = 0.f;
#pragma unroll
                for (int j = 0; j < 8; ++j) { v[rr][j] = v[rr][j] - mean[rr]; s2[rr] += (v[rr][j].x * v[rr][j].x + v[rr][j].y * v[rr][j].y) + (v[rr][j].z * v[rr][j].z + v[rr][j].w * v[rr][j].w); } }
#pragma unroll
            for (int rr = 0; rr < 2; ++rr) rstd[rr] = 1.f / sqrtf(wave_sum(s2[rr]) * (1.f / D) + EPS);
            const int b = (tile * 16) / S;
            const f32x4* sh = (const f32x4*)(F.ada + (size_t)b * 6 * D + 3 * D) + lane;
            const f32x4* scp = (const f32x4*)(F.ada + (size_t)b * 6 * D + 4 * D) + lane;
#pragma unroll
            for (int j = 0; j < 8; ++j) { const f32x4 sc1 = scp[64 * j] + 1.f, shj = sh[64 * j];
#pragma unroll
                for (int rr = 0; rr < 2; ++rr) {
                    const int row = wid * 2 + rr;
                    const f32x4 y = v[rr][j] * rstd[rr] * sc1 + shj;
                    const u32x2 w = {pk_f16(y.x, y.y), pk_f16(y.z, y.w)};
                    ((unsigned*)((unsigned char*)F.hA + (size_t)(tile * 16 + row) * D) + lane)[64 * j] = pk4_fp8(y.x, y.y, y.z, y.w);
                    const int chunk = (lane >> 1) + 32 * j;
                    *(LAS u32x2*)(lds + row * 4096 + ((chunk ^ row) << 4) + 8 * (lane & 1)) = w;
                } }
        }
        __syncthreads();
        {
            f32x4 d0 = {0.f, 0.f, 0.f, 0.f}, d1 = d0;
            const int ar = lane & 15, aq = lane >> 4;
#pragma unroll
            for (int s2 = 0; s2 < 8; ++s2) {
                const int kk = 256 * wid + 32 * s2 + 8 * aq;
                const f16x8 a = *(const LAS f16x8*)(lds + ar * 4096 + ((((kk >> 3)) ^ ar) << 4));
                const f16x8 b0 = *(const f16x8*)(F.WrT + (size_t)ar * D + kk), b1 = *(const f16x8*)(F.WrT + (size_t)(16 + ar) * D + kk);
                d0 = __builtin_amdgcn_mfma_f32_16x16x32_f16(a, b0, d0, 0, 0, 0);
                d1 = __builtin_amdgcn_mfma_f32_16x16x32_f16(a, b1, d1, 0, 0, 0);
            }
#pragma unroll
            for (int r = 0; r < 4; ++r) { part[(wid * 16 + 4 * aq + r) * 32 + ar] = d0[r]; part[(wid * 16 + 4 * aq + r) * 32 + 16 + ar] = d1[r]; }
        }
        __syncthreads();
#pragma unroll 1
        for (int rr = 0; rr < 2; ++rr) {
            const int row = wid * 2 + rr, m = tile * 16 + row;
            float myv = -INFINITY;
            if (lane < 32) { float a = F.b_router[lane];
#pragma unroll
                for (int w = 0; w < 8; ++w) a += part[(w * 16 + row) * 32 + lane];
                myv = a; }
            int se[4]; float sv[4];
#pragma unroll
            for (int k = 0; k < 4; ++k) {
                float bv = myv; int bi = lane;
#pragma unroll
                for (int o = 1; o < 64; o <<= 1) { const float ov = __shfl_xor(bv, o); const int oi = __shfl_xor(bi, o); if (ov > bv || (ov == bv && oi < bi)) { bv = ov; bi = oi; } }
                se[k] = bi; sv[k] = bv; if (lane == bi) myv = -INFINITY;
            }
            const float e0 = 1.f, e1 = expf(sv[1] - sv[0]), e2 = expf(sv[2] - sv[0]), e3 = expf(sv[3] - sv[0]);
            const float inv = 1.f / (e0 + e1 + e2 + e3);
            if (lane < 4) {
                const int e = lane == 0 ? se[0] : lane == 1 ? se[1] : lane == 2 ? se[2] : se[3];
                const float gv = (lane == 0 ? e0 : lane == 1 ? e1 : lane == 2 ? e2 : e3) * inv;
                const unsigned p = atomicAdd(F.ctl + CW_CNT + e, 1u);
                F.list[(size_t)e * LISTCAP + p] = m * 4 + lane;
                F.tope[m * 4 + lane] = e; F.gate[m * 4 + lane] = gv;
            }
        }
    }
}
DEVINL void p_bridge_proj(Frame& F) {
    const int gw = F.bid * NWAVES + F.wave, NGW = F.G * NWAVES, lane = F.lane;
    for (int m = gw; m < NT; m += NGW) {
        const f16* ph = F.projh + (size_t)m * NV; float* p = F.proj + (size_t)m * INW;
        const float pos = (float)F.pos[m];
        float sq = 0.f, skv = 0.f;
        if (lane < 16) sq = F.ssq[(size_t)m * 16 + lane];
        if (lane < 8) skv = F.sskv[(size_t)m * 8 + lane];
        const float rq = 1.f / sqrtf(wave_sum(sq) * (1.f / 512.f) + EPS), rkv = 1.f / sqrtf(wave_sum(skv) * (1.f / 256.f) + EPS);
        if (lane == 0) { F.rq[m] = rq; F.rkv[m] = rkv; }
        for (int pc = lane; pc < INW; pc += 64) {
            if (pc >= O_IK && pc < O_IW) continue;
            float v = (float)ph[vcol_in(pc)];
            if (pc >= O_QD && pc < O_KVD) v = v * rq * F.qng[pc - O_QD];
            else if (pc >= O_KVD && pc < O_KR) v = v * rkv * F.kvng[pc - O_KVD];
            p[pc] = v;
        }
        {
            const float v = (float)ph[lane < 32 ? V_IK_LO + permI(lane) : V_IK_HI + (lane - 32)];
            const float mean = wave_sum(v) * (1.f / 64.f);
            const float d = v - mean;
            const float var = wave_sum(d * d) * (1.f / 64.f);
            float y = d * (1.f / sqrtf(var + EPS)) * F.ikg[lane] + F.ikb[lane];
            const float other = __shfl_xor(y, 8);
            float c, s; rope_cs(pos, lane & 7, 8, c, s);
            if (lane < 8) y = y * c - other * s; else if (lane < 16) y = y * c + other * s;
            p[O_IK + lane] = y;
        }
    }
}

#define XB_TMO      128
#define XB_XCNT(j)  (256  + 64 * (j))
#define XB_XSUB(j)  (1280 + 64 * (j))
#define XB_XGEN(j)  (2304 + 64 * (j))
#define XB_TOP      3328
#define XB_TOPGEN   3392
#define XCD_BAR_WORDS 3456
#define XB_SPIN_CAP (1u << 22)
__device__ __forceinline__ unsigned xb_ld(unsigned* p)              { return __hip_atomic_load(p, __ATOMIC_RELAXED, __HIP_MEMORY_SCOPE_AGENT); }
__device__ __forceinline__ unsigned xb_add(unsigned* p, unsigned v) { return __hip_atomic_fetch_add(p, v, __ATOMIC_RELAXED, __HIP_MEMORY_SCOPE_AGENT); }
__device__ __forceinline__ unsigned xb_xcc_id() { return (unsigned)__builtin_amdgcn_s_getreg((3 << 11) | 20) & 0xFu; }
#define XB_SPIN(cond, bar) do { unsigned _sp = 0; while (cond) { __builtin_amdgcn_s_sleep(1); \
    if ((++_sp & 255u) == 0u) { if (xb_ld(&(bar)[XB_TMO])) break; if (_sp > XB_SPIN_CAP) { atomicAdd(&(bar)[XB_TMO], 1u); break; } } } } while (0)
struct XcdBarrier { unsigned* bar; unsigned x; volatile LAS unsigned* st; };
__device__ __forceinline__ XcdBarrier xcd_barrier_post(unsigned* bar, volatile LAS unsigned* st) {
    XcdBarrier b; b.bar = bar; b.x = xb_xcc_id(); b.st = st;
    if (threadIdx.x == 0) (void)xb_add(&bar[XB_XCNT(b.x)], 1u);
    return b;
}
__device__ __forceinline__ void xcd_barrier_complete(unsigned* bar, unsigned x, unsigned& nloc, unsigned& nx) {
    const unsigned G = gridDim.x * gridDim.y * gridDim.z;
    unsigned sum, cnt, mine, sp = 0u;
    for (;;) {
        sum = 0u; cnt = 0u; mine = 0u;
#pragma unroll
        for (unsigned j = 0; j < 16; ++j) { const unsigned c = xb_ld(&bar[XB_XCNT(j)]); sum += c; cnt += (c > 0u) ? 1u : 0u; mine = (j == x) ? c : mine; }
        if (sum == G) break;
        __builtin_amdgcn_s_sleep(1);
        if ((++sp & 255u) == 0u) { if (xb_ld(&bar[XB_TMO])) break; if (sp > XB_SPIN_CAP) { atomicAdd(&bar[XB_TMO], 1u); break; } }
    }
    nloc = mine > 0u ? mine : 1u; nx = cnt > 0u ? cnt : 1u;
}
__device__ __forceinline__ void xcd_barrier(const XcdBarrier& b) {
    asm volatile("s_waitcnt vmcnt(0)" ::: "memory");
    __syncthreads();
    if (threadIdx.x == 0) {
        unsigned* bar = b.bar;
        __builtin_amdgcn_s_waitcnt(0);
        unsigned nloc = b.st[0], nx = b.st[1];
        if (nloc == 0u) { xcd_barrier_complete(bar, b.x, nloc, nx); b.st[0] = nloc; b.st[1] = nx; }
        const unsigned old = xb_add(&bar[XB_XSUB(b.x)], 1u);
        const unsigned gen = old / nloc;
        if (old + 1u == (gen + 1u) * nloc) {
            __builtin_amdgcn_fence(__ATOMIC_RELEASE, "agent");
            asm volatile("s_waitcnt vmcnt(0)" ::: "memory");
            const unsigned og = xb_add(&bar[XB_TOP], 1u);
            const unsigned tg = og / nx;
            if (og + 1u == (tg + 1u) * nx) xb_add(&bar[XB_TOPGEN], 1u);
            else XB_SPIN(xb_ld(&bar[XB_TOPGEN]) == tg, bar);
            __builtin_amdgcn_fence(__ATOMIC_ACQUIRE, "agent");
            xb_add(&bar[XB_XGEN(b.x)], 1u);
            asm volatile("s_waitcnt vmcnt(0)" ::: "memory");
        } else {
            XB_SPIN(xb_ld(&bar[XB_XGEN(b.x)]) == gen, bar);
            __builtin_amdgcn_fence(__ATOMIC_ACQUIRE, "agent");
            asm volatile("s_waitcnt vmcnt(0)" ::: "memory");
        }
    }
    __syncthreads();
}

DEVINL void* ldp(volatile LAS unsigned* A, int i) {
    const unsigned lo = __builtin_amdgcn_readfirstlane(A[2 * i]), hi = __builtin_amdgcn_readfirstlane(A[2 * i + 1]);
    return (void*)(((u64)hi << 32) | lo);
}
DEVINL void build_frame(Frame& F, volatile LAS unsigned* A) {
    { int t_ = threadIdx.x; asm volatile("" : "+v"(t_)); F.tid = t_; } F.lane = F.tid & 63; F.wave = __builtin_amdgcn_readfirstlane(F.tid >> 6); F.G = gridDim.x; F.bid = blockIdx.x;
    F.x = (const float*)ldp(A, 0); F.c = (const float*)ldp(A, 1); F.pos = (const int*)ldp(A, 2); F.w_ada = (const float*)ldp(A, 3); F.b_ada = (const float*)ldp(A, 4);
    F.w_in = (const float*)ldp(A, 5); F.ikg = (const float*)ldp(A, 6); F.ikb = (const float*)ldp(A, 7); F.qng = (const float*)ldp(A, 8); F.w_q_up = (const float*)ldp(A, 9);
    F.kvng = (const float*)ldp(A, 10); F.w_kv_up = (const float*)ldp(A, 11); F.onag = (const float*)ldp(A, 12); F.onbg = (const float*)ldp(A, 13); F.w_out = (const float*)ldp(A, 14);
    F.lnmg = (const float*)ldp(A, 15); F.lnmb = (const float*)ldp(A, 16); F.w_router = (const float*)ldp(A, 17); F.b_router = (const float*)ldp(A, 18);
    F.w_gu = (const float*)ldp(A, 19); F.b_gu = (const float*)ldp(A, 20); F.w_dn = (const float*)ldp(A, 21); F.b_dn = (const float*)ldp(A, 22); F.lnfg = (const float*)ldp(A, 23); F.lnfb = (const float*)ldp(A, 24);
    F.out = (float*)ldp(A, 25);
    unsigned char* ws = (unsigned char*)ldp(A, 26);
    F.ctl = (unsigned*)(ws + WS_CTL); F.ada = (float*)(ws + WS_ADA); F.list = (int*)(ws + WS_LIST); F.tope = (int*)(ws + WS_TOPE); F.gate = (float*)(ws + WS_GATE); F.mask = (u64*)(ws + WS_MASK);
    F.h = (float*)(ws + WS_H); F.proj = (float*)(ws + WS_PROJ); F.qb = (float*)(ws + WS_QB); F.kv = (float*)(ws + WS_KV); F.oab = (float*)(ws + WS_OAB); F.x1 = (float*)(ws + WS_X1);
    F.act = (float*)(ws + WS_ACT); F.y = (float*)(ws + WS_Y);
    F.WinT = (f16*)(ws + WS_WINT); F.hA = (f16*)(ws + WS_HA); F.projh = (f16*)(ws + WS_PROJH); F.tab = (float*)(ws + WS_TAB); F.ssq = (float*)(ws + WS_SSQ); F.sskv = (float*)(ws + WS_SSKV);
    F.WoutT = (f16*)(ws + WS_WOUTT); F.WguT = (f16*)(ws + WS_WGUT); F.WdT = (f16*)(ws + WS_WDT); F.bguP = (float*)(ws + WS_BGUP); F.mrgh = (f16*)(ws + WS_MRGH); F.act16 = (f16*)(ws + WS_ACT16); F.y16 = (f16*)(ws + WS_Y16);
    F.WqupT = (f16*)(ws + WS_WQUPT); F.WkvupT = (f16*)(ws + WS_WKVUPT); F.qb16 = (f16*)(ws + WS_QB16); F.kv16 = (f16*)(ws + WS_KV16); F.att16 = (f16*)(ws + WS_ATT16); F.WrT = (f16*)(ws + WS_WRT); F.ikv = (float*)(ws + WS_IKV); F.score = (float*)(ws + WS_SCORE); F.rq = (float*)(ws + WS_RQ); F.rkv = (float*)(ws + WS_RKV);
}
template <int PLO, int PHI> __global__ void __launch_bounds__(NTHREADS, 2) fwd(Args args) {
    extern __shared__ __attribute__((aligned(16))) unsigned char lds_raw[];
    float* lds = (float*)lds_raw;
    volatile LAS unsigned* argl = (volatile LAS unsigned*)((LAS unsigned char*)lds_raw + (LDS_BYTES - 512));
    if (threadIdx.x < 54) argl[threadIdx.x] = ((const unsigned*)&args)[threadIdx.x];
    __syncthreads();
    Frame F; build_frame(F, argl);
#define IN(k) (PLO <= (k) && (k) < PHI)
    volatile LAS unsigned* xbst = (volatile LAS unsigned*)((LAS unsigned char*)lds_raw + (LDS_BYTES - 16));
    XcdBarrier bar; bar.bar = F.ctl + CW_BAR; bar.x = 0; bar.st = xbst;
    if constexpr (PHI - PLO > 1) {
        if (F.tid == 0) { xbst[0] = 0u; xbst[1] = 0u; xbst[2] = 0u; xbst[3] = 0u; }
        __syncthreads();
        bar = xcd_barrier_post(F.ctl + CW_BAR, xbst);
    }
#define SEAM(k) do { if constexpr (IN(k) && IN((k) + 1)) xcd_barrier(bar); } while (0)

    if constexpr (IN(0)) for (int rep_ = 0; rep_ < REPS(0); ++rep_) p_ada(F, lds);
    SEAM(0); build_frame(F, argl);
    if constexpr (IN(1)) for (int rep_ = 0; rep_ < REPS(1); ++rep_) {
        const int nconv = (F.G >= 2 * CONV_C && ((F.G - CONV_C) & 7) == 0) ? CONV_C : 0, G2 = F.G - nconv;
        if (F.bid >= G2) p_moeconv(F, lds, (F.bid - G2) * NWAVES + F.wave, nconv * NWAVES, 0, HEAD_STEPS);
        else p_prologue(F, lds, F.bid * NWAVES + F.wave, G2 * NWAVES);
    }
    SEAM(1); build_frame(F, argl);
    if constexpr (IN(2)) for (int rep_ = 0; rep_ < REPS(2); ++rep_) {
        const int nconv = (F.G >= 2 * CONV_C && ((F.G - CONV_C) & 7) == 0) ? CONV_C : 0, G2 = F.G - nconv;
        if (F.bid >= G2) p_moeconv(F, lds, (F.bid - G2) * NWAVES + F.wave, nconv * NWAVES, HEAD_STEPS);
        else {
            if (nconv == 0) { p_moeconv(F, lds, F.bid * NWAVES + F.wave, F.G * NWAVES); __syncthreads(); build_frame(F, argl); }
            g16::Gemm g{F.hA, F.WinT, D, D, D}; g16::StaticOrder So; So.init(NT, NV, G2, F.bid, P2_WGM);
            EpiInProj E{F.projh, F.tab, F.ssq, F.sskv, F.ikv};
            g16::gemm_phase<EpiInProj, g16::StaticOrder>((LAS unsigned char*)lds_raw, g, So, E);
        }
    }
    SEAM(2); build_frame(F, argl);
#if EXTRA_BARRIERS
    for (int xb_ = 0; xb_ < EXTRA_BARRIERS; ++xb_) xcd_barrier(bar);
#endif
#if DUMMY_GEMM
    {
        g16::Gemm g{F.hA, F.WinT, D, D, D}; g16::StaticOrder So; So.init(NT, NV, F.G, F.bid);
        EpiPlain E{F.act16};
        g16::gemm_phase<EpiPlain, g16::StaticOrder>((LAS unsigned char*)lds_raw, g, So, E);
        __syncthreads(); build_frame(F, argl);
    }
#endif
    if constexpr (IN(4)) for (int rep_ = 0; rep_ < REPS(4); ++rep_) {
        { g16::Gemm g{F.projh + V_QD, F.WqupT, NV, 512, 512}; g16::StaticOrder So; So.init(NT, 1536, F.G, F.bid); EpiQup E{F.qb16, F.tab, F.ssq};
          g16::gemm_phase<EpiQup, g16::StaticOrder>((LAS unsigned char*)lds_raw, g, So, E); }
    }
    __syncthreads(); build_frame(F, argl);
    if constexpr (IN(5)) for (int rep_ = 0; rep_ < REPS(5); ++rep_) {
        g16::Gemm g{F.projh + V_KVD, F.WkvupT, NV, 256, 256}; g16::StaticOrder So; So.init(NT, D, F.G, F.bid); EpiKVup E{F.kv16, F.sskv};
        g16::gemm_phase<EpiKVup, g16::StaticOrder>((LAS unsigned char*)lds_raw, g, So, E);
    }
    __syncthreads(); build_frame(F, argl);
    if constexpr (IN(6)) for (int rep_ = 0; rep_ < REPS(6); ++rep_) p_index16(F, (LAS unsigned char*)lds_raw, rep_ * PROBE_IDX);
    SEAM(6); build_frame(F, argl);
    if constexpr (IN(7)) for (int rep_ = 0; rep_ < REPS(7); ++rep_) p_topk16(F, (LAS unsigned char*)lds_raw);
    SEAM(7); build_frame(F, argl);
    if constexpr (IN(8)) for (int rep_ = 0; rep_ < REPS(8); ++rep_) p_attn16(F, (LAS unsigned char*)lds_raw, rep_ * PROBE_ATT);
    SEAM(8); build_frame(F, argl);
    if constexpr (IN(9)) for (int rep_ = 0; rep_ < REPS(9); ++rep_) p_merge16(F);
    SEAM(9); build_frame(F, argl);
    if constexpr (IN(10)) for (int rep_ = 0; rep_ < REPS(10); ++rep_) {
#if OUTPROJ_F8
        g16::Gemm g{F.mrgh, F.WoutT, D / 2, D / 2, D / 2, 1}; g16::StaticOrder So; So.init(NT, D, F.G, F.bid);
        EpiPre16 E{(f16*)F.x1, F.x, F.ada, W8_INV};
        g16::gemm_phase<EpiPre16, g16::StaticOrder, true, true>((LAS unsigned char*)lds_raw, g, So, E);
#else
        g16::Gemm g{F.mrgh, F.WoutT, D, D, D}; g16::StaticOrder So; So.init(NT, D, F.G, F.bid);
        EpiPre16 E{(f16*)F.x1, F.x, F.ada, 1.f};
        g16::gemm_phase<EpiPre16, g16::StaticOrder>((LAS unsigned char*)lds_raw, g, So, E);
#endif
    }
    SEAM(10); build_frame(F, argl);
    if constexpr (IN(11)) for (int rep_ = 0; rep_ < REPS(11); ++rep_) p_router16(F, (LAS unsigned char*)lds_raw);
    SEAM(11); build_frame(F, argl);
#if MOE_FAST
    if constexpr (IN(12)) for (int rep_ = 0; rep_ < REPS(12); ++rep_) {
        LAS MoeLds* T = (LAS MoeLds*)((LAS unsigned char*)lds_raw + 131072 + 1024);
        moe_lds_build(F, T);
        g16::Gemm g{F.hA, F.WguT, D / 2, D / 2, D / 2, 1}; MoeOrder<2> So{T, F.list, F.bid & 7, F.bid >> 3, F.G >> 3};
        EpiGU8 E{(unsigned char*)F.act16, F.bguP, rep_ * PROBE_IDX};
        g16::gemm_phase<EpiGU8, MoeOrder<2>, true, true>((LAS unsigned char*)lds_raw, g, So, E);
    }
    SEAM(12); build_frame(F, argl);
    if constexpr (IN(13)) for (int rep_ = 0; rep_ < REPS(13); ++rep_) {
        LAS MoeLds* T = (LAS MoeLds*)((LAS unsigned char*)lds_raw + 131072 + 1024);
        moe_lds_build(F, T);
        g16::Gemm g{F.act16, F.WdT, DFF / 2, DFF / 2, DFF / 2, 1}; MoeOrder<1> So{T, F.list, F.bid & 7, F.bid >> 3, F.G >> 3};
        EpiDown16 E{F.y16, F.b_dn, F.list, F.gate, T, W8_INV};
        g16::gemm_phase<EpiDown16, MoeOrder<1>, true, true>((LAS unsigned char*)lds_raw, g, So, E);
    }
    SEAM(13); build_frame(F, argl);
    if constexpr (IN(14)) for (int rep_ = 0; rep_ < REPS(14); ++rep_) p_final16(F);
#else
    if constexpr (IN(12)) for (int rep_ = 0; rep_ < REPS(12); ++rep_) {
        MoeTab* tb = (MoeTab*)(lds + 32 * 129 + 32 * 256);
        moe_tab(F, tb);
        const int ntile = tb->tstart[NE];
        for (int u = F.bid; u < ntile * 16; u += F.G) {
            const int rt = u >> 4, ct = u & 15; int e = 0;
            while (e < NE - 1 && rt >= tb->tstart[e + 1]) ++e;
            const int r0 = (rt - tb->tstart[e]) * 128, cnt = tb->cnt[e];
            RowGatherH rp{F.h, F.list + (size_t)e * LISTCAP, r0, cnt};
            EpiGU ep{F.act, F.b_gu + (size_t)e * 2 * DFF, tb->offs[e], r0, cnt, F.lane};
            gemm_tile_f32(lds, rp, F.w_gu + (size_t)e * D * 2 * DFF, 2 * DFF, D, ct * 256, 2 * DFF, ep);
        }
    }
    SEAM(12); build_frame(F, argl);
    if constexpr (IN(13)) for (int rep_ = 0; rep_ < REPS(13); ++rep_) {
        MoeTab* tb = (MoeTab*)(lds + 32 * 129 + 32 * 256);
        moe_tab(F, tb);
        const int ntile = tb->tstart[NE];
        for (int u = F.bid; u < ntile * 8; u += F.G) {
            const int rt = u >> 3, ct = u & 7; int e = 0;
            while (e < NE - 1 && rt >= tb->tstart[e + 1]) ++e;
            const int r0 = (rt - tb->tstart[e]) * 128, cnt = tb->cnt[e];
            RowAct rp{F.act, tb->offs[e], r0, cnt};
            EpiDown ep{F.y, F.b_dn + (size_t)e * D, F.list + (size_t)e * LISTCAP, F.gate, r0, cnt};
            gemm_tile_f32(lds, rp, F.w_dn + (size_t)e * DFF * D, D, DFF, ct * 256, D, ep);
        }
    }
    SEAM(13); build_frame(F, argl);
    if constexpr (IN(14)) for (int rep_ = 0; rep_ < REPS(14); ++rep_) p_final(F);
#endif
#undef IN
}

constexpr int NPHASE = 15;
template <int P> static void launch_one(int grid, hipStream_t stream, const Args& a) {
    static bool attr = false;
    if (!attr) { (void)hipFuncSetAttribute((const void*)fwd<P, P + 1>, hipFuncAttributeMaxDynamicSharedMemorySize, LDS_BYTES); attr = true; }
    hipLaunchKernelGGL((fwd<P, P + 1>), dim3(grid), dim3(NTHREADS), LDS_BYTES, stream, a);
}
template <int P> static void launch_all(int grid, hipStream_t stream, const Args& a) {
    if constexpr (P < NPHASE) {
        launch_one<P>(grid, stream, a);
        launch_all<P + 1>(grid, stream, a);
    }
}
extern "C" void kernel_launch(void* const* d_in, const int* in_sizes, int n_in, void* d_out, int out_size, void* d_ws, size_t ws_size, hipStream_t stream) {
    static int grid = 0;
    if (grid == 0) {
        if (n_in != 25 || out_size != NT * D || ws_size < WS_END4) { fprintf(stderr, "kernel_launch: unexpected shapes (n_in %d out %d ws %zu)\n", n_in, out_size, ws_size); grid = -1; return; }
        int dev = 0, cus = 0;
        if (hipGetDevice(&dev) != hipSuccess || hipDeviceGetAttribute(&cus, hipDeviceAttributeMultiprocessorCount, dev) != hipSuccess) { grid = -1; return; }
        grid = cus;
    }
    if (grid < 0) return;
    (void)hipMemsetAsync((char*)d_ws + WS_CTL, 0, CTL_ZERO_BYTES, stream);
    Args a{};
    for (int i = 0; i < 25; ++i) a.in[i] = d_in[i];
    a.out = (float*)d_out; a.ws = (unsigned char*)d_ws;
#if MULTI_LAUNCH
    launch_all<0>(grid, stream, a);
#else
    static bool attr = false;
    if (!attr) { (void)hipFuncSetAttribute((const void*)fwd<0, NPHASE>, hipFuncAttributeMaxDynamicSharedMemorySize, LDS_BYTES); attr = true; }
    hipLaunchKernelGGL((fwd<0, NPHASE>), dim3(grid), dim3(NTHREADS), LDS_BYTES, stream, a);
#endif
}
```

```cpp
#include <hip/hip_runtime.h>
#include <stdint.h>
#include <stdio.h>

#define DEVINL __device__ __forceinline__
#ifndef REPEAT_P
#define REPEAT_P 0
#endif
#ifndef P2_WGM
#define P2_WGM 4
#endif
#ifndef HEAD_STEPS
#define HEAD_STEPS 21
#endif
#ifndef CONV_C
#define CONV_C 96
#endif
#ifndef PROBE_ATT
#define PROBE_ATT 0
#endif
#ifndef PROBE_IDX
#define PROBE_IDX 0
#endif
#ifndef OUTPROJ_F8
#define OUTPROJ_F8 1
#endif
#ifndef EXTRA_BARRIERS
#define EXTRA_BARRIERS 0
#endif
#ifndef DUMMY_READ
#define DUMMY_READ 0
#endif
#ifndef DUMMY_GEMM
#define DUMMY_GEMM 0
#endif
#define REPS(k) (((REPEAT_P >> (k)) & 1) ? 2 : 1)
#ifndef MULTI_LAUNCH
#define MULTI_LAUNCH 0
#endif
#ifndef MOE_FAST
#define MOE_FAST 1
#endif
typedef float f32x4 __attribute__((ext_vector_type(4)));
typedef float f32x2 __attribute__((ext_vector_type(2)));
typedef float f32x16 __attribute__((ext_vector_type(16)));
typedef unsigned long long u64;
typedef _Float16 f16;
typedef _Float16 f16x8 __attribute__((ext_vector_type(8)));
typedef _Float16 f16x2 __attribute__((ext_vector_type(2)));
typedef unsigned u32x4 __attribute__((ext_vector_type(4)));
typedef unsigned u32x2 __attribute__((ext_vector_type(2)));
#define LAS __attribute__((address_space(3)))

constexpr int D = 2048, NB = 4, S = 4096, NT = NB * S, INW = 5008;
constexpr int O_AQ = 0, O_AK = 1024, O_AV = 2048, O_IQ = 3072, O_IK = 4096, O_IW = 4160, O_QD = 4176, O_KVD = 4688, O_KR = 4944;
constexpr int NE = 32, DFF = 2048, LISTCAP = NT;
constexpr float EPS = 1e-5f, ALPHA = 1.18920711500272106672f, INDEX_SCALE = 0.03125f;
constexpr float THETA = 500000.0f;
constexpr int NWAVES = 8, NTHREADS = 512;
constexpr int LDS_BYTES = 147456;

constexpr size_t MiB = 1u << 20;
constexpr size_t WS_CTL = 0, CTL_ZERO_BYTES = 1 * MiB;
constexpr size_t WS_ADA = 1 * MiB, WS_LIST = 2 * MiB, WS_TOPE = 4 * MiB, WS_GATE = 5 * MiB, WS_MASK = 8 * MiB;
constexpr size_t WS_H = 16 * MiB, WS_PROJ = 144 * MiB, WS_QB = 460 * MiB, WS_KV = 556 * MiB, WS_OAB = 684 * MiB, WS_X1 = 812 * MiB;
constexpr size_t WS_ACT = 940 * MiB, WS_Y = 1452 * MiB, WS_END = 1964 * MiB;
constexpr int CW_CNT = 16384, CW_BAR = 4096, CW_ADA = 20480;
constexpr size_t WS_WINT = 1964 * MiB, WS_HA = 1984 * MiB, WS_PROJH = 2048 * MiB, WS_TAB = 2208 * MiB, WS_SSQ = 2216 * MiB, WS_SSKV = 2217 * MiB, WS_END2 = 2218 * MiB;
constexpr size_t WS_WOUTT = 2220 * MiB, WS_WGUT = 2228 * MiB, WS_WDT = 2740 * MiB, WS_BGUP = 2996 * MiB, WS_MRGH = 2998 * MiB, WS_ACT16 = 3062 * MiB, WS_Y16 = 3350 * MiB, WS_END3 = 3606 * MiB;
constexpr size_t WS_IKV = 3790 * MiB;
constexpr size_t WS_WRT = 3789 * MiB;
constexpr size_t WS_SCORE = 16 * MiB;
constexpr size_t WS_RQ = 3786 * MiB, WS_RKV = 3787 * MiB;
constexpr size_t WS_WQUPT = 3606 * MiB, WS_WKVUPT = 3608 * MiB, WS_QB16 = 3610 * MiB, WS_KV16 = 3658 * MiB, WS_ATT16 = 3722 * MiB, WS_END4 = 3791 * MiB;
constexpr int NV = 5120;
constexpr int V_AQ = 0, V_AK = 1024, V_AV = 2048, V_IQ = 3072, V_QD = 4096, V_KVD = 4608, V_IK_LO = 4864, V_IW = 4896, V_KR = 4928, V_IK_HI = 4992;
constexpr int TABW = 112, T_CA = 0, T_SA = 16, T_CI = 32, T_SI = 40, T_CR = 48, T_SR = 80;

struct Args { const void* in[25]; float* out; unsigned char* ws; int ph_lo, ph_hi; };

struct Frame {
    int tid, lane, wave, G, bid;
    const float *x, *c, *w_ada, *b_ada, *w_in, *ikg, *ikb, *qng, *w_q_up, *kvng, *w_kv_up, *onag, *onbg, *w_out, *lnmg, *lnmb, *w_router, *b_router, *w_gu, *b_gu, *w_dn, *b_dn, *lnfg, *lnfb;
    const int* pos;
    float* out;
    unsigned* ctl; float* ada; int* list; int* tope; float* gate; u64* mask;
    float *h, *proj, *qb, *kv, *oab, *x1, *act, *y;
    f16 *WinT, *hA, *projh; float *tab, *ssq, *sskv;
    f16 *WoutT, *WguT, *WdT, *mrgh, *act16, *y16; float* bguP;
    f16 *WqupT, *WkvupT, *qb16, *kv16, *att16; float *rq, *rkv, *score; f16* WrT; float* ikv;
};

DEVINL float wave_sum(float v) {
#define WS_DPP(ctrl_, rm_) v += __builtin_bit_cast(float, __builtin_amdgcn_update_dpp(0, __builtin_bit_cast(int, v), ctrl_, rm_, 0xf, false))
    WS_DPP(0x111, 0xf); WS_DPP(0x112, 0xf); WS_DPP(0x114, 0xf); WS_DPP(0x118, 0xf); WS_DPP(0x142, 0xa); WS_DPP(0x143, 0xc);
#undef WS_DPP
    return __builtin_bit_cast(float, __builtin_amdgcn_readlane(__builtin_bit_cast(int, v), 63));
}
typedef _Float16 f16x4 __attribute__((ext_vector_type(4)));
DEVINL f32x4 ld4h(const f16* p) { const f16x4 h = *(const f16x4*)p; return __builtin_convertvector(h, f32x4); }
DEVINL unsigned pk_f16(float lo, float hi) { const f16x2 h = {(f16)lo, (f16)hi}; return __builtin_bit_cast(unsigned, h); }
DEVINL void rope_cs(float pos, int i, int half, float& c, float& s) {
    const float inv = powf(THETA, -(float)i / (float)half);
    const float ang = pos * inv;
    sincosf(ang, &s, &c);
}

template <class RowPtr, class Epi>
DEVINL void gemm_tile_f32(float* lds, const RowPtr& rowptr, const float* __restrict__ Bm, int ldb, int Kd, int n0, int N, const Epi& epi) {
    float* As = lds;
    float* Bs = lds + 32 * 129;
    int tid_ = threadIdx.x; asm volatile("" : "+v"(tid_));
    const int tid = tid_, lane = tid & 63, wid = tid >> 6, wm = wid >> 2, wn = wid & 3;
    const int arow = tid >> 2, akq = tid & 3;
    const float* ap = rowptr(arow) + akq * 8;
    const int bk = tid >> 4, bn = (tid & 15) * 16;
    const float* bp = Bm + (size_t)bk * ldb + n0 + bn;
    f32x16 acc[2][2];
#pragma unroll
    for (int i = 0; i < 2; ++i)
#pragma unroll
        for (int j = 0; j < 2; ++j)
#pragma unroll
            for (int r = 0; r < 16; ++r) acc[i][j][r] = 0.f;
    f32x4 ra[2], rb[4];
    const f32x4 z4 = {0.f, 0.f, 0.f, 0.f};
    ra[0] = *(const f32x4*)(ap); ra[1] = *(const f32x4*)(ap + 4);
#pragma unroll
    for (int i = 0; i < 4; ++i) rb[i] = (n0 + bn + 4 * i < N) ? *(const f32x4*)(bp + 4 * i) : z4;
    for (int k0 = 0; k0 < Kd; k0 += 32) {
        __syncthreads();
#pragma unroll
        for (int j = 0; j < 8; ++j) As[(akq * 8 + j) * 129 + arow] = ra[j >> 2][j & 3];
#pragma unroll
        for (int i = 0; i < 4; ++i) *(f32x4*)(Bs + bk * 256 + bn + 4 * i) = rb[i];
        __syncthreads();
        if (k0 + 32 < Kd) {
            ra[0] = *(const f32x4*)(ap + k0 + 32); ra[1] = *(const f32x4*)(ap + k0 + 36);
#pragma unroll
            for (int i = 0; i < 4; ++i) rb[i] = (n0 + bn + 4 * i < N) ? *(const f32x4*)(bp + (size_t)(k0 + 32) * ldb + 4 * i) : z4;
        }
#pragma unroll
        for (int kk = 0; kk < 32; kk += 2) {
            const int kr = kk + (lane >> 5);
            const float a0 = As[kr * 129 + wm * 64 + (lane & 31)], a1 = As[kr * 129 + wm * 64 + 32 + (lane & 31)];
            const float b0 = Bs[kr * 256 + wn * 64 + (lane & 31)], b1 = Bs[kr * 256 + wn * 64 + 32 + (lane & 31)];
            acc[0][0] = __builtin_amdgcn_mfma_f32_32x32x2f32(a0, b0, acc[0][0], 0, 0, 0);
            acc[0][1] = __builtin_amdgcn_mfma_f32_32x32x2f32(a0, b1, acc[0][1], 0, 0, 0);
            acc[1][0] = __builtin_amdgcn_mfma_f32_32x32x2f32(a1, b0, acc[1][0], 0, 0, 0);
            acc[1][1] = __builtin_amdgcn_mfma_f32_32x32x2f32(a1, b1, acc[1][1], 0, 0, 0);
        }
    }
#pragma unroll
    for (int i = 0; i < 2; ++i)
#pragma unroll
        for (int j = 0; j < 2; ++j)
#pragma unroll
            for (int r = 0; r < 16; ++r) {
                const int row = wm * 64 + i * 32 + (r & 3) + 8 * (r >> 2) + 4 * (lane >> 5);
                const int col = n0 + wn * 64 + j * 32 + (lane & 31);
                epi(row, col, acc[i][j][r]);
            }
    __syncthreads();
}

struct RowLin { const float* base; size_t ld; int m0; DEVINL const float* operator()(int r) const { return base + (size_t)(m0 + r) * ld; } };

DEVINL void p_ada(Frame& F, float* lds) {
    float* sc = lds;
    float* red = lds + 4 * D;
    for (int i = F.tid; i < 4 * D; i += NTHREADS) { const float v = F.c[i]; sc[i] = v / (1.f + expf(-v)); }
    __syncthreads();
    const int cg = F.tid & 15, kp = F.tid >> 4;
    for (int u = F.bid; u < 6 * D / 64; u += F.G) {
        const float* wp = F.w_ada + (size_t)kp * (6 * D) + u * 64 + 4 * cg;
        f32x4 a0 = {0.f, 0.f, 0.f, 0.f}, a1 = a0, a2 = a0, a3 = a0;
#pragma unroll 8
        for (int i = 0; i < 64; ++i) {
            const int k = kp + 32 * i;
            const f32x4 w = *(const f32x4*)(wp + (size_t)(32 * i) * (6 * D));
            a0 += w * sc[k]; a1 += w * sc[D + k]; a2 += w * sc[2 * D + k]; a3 += w * sc[3 * D + k];
        }
        float* rp = red + (kp * 16 + cg) * 16;
        *(f32x4*)(rp) = a0; *(f32x4*)(rp + 4) = a1; *(f32x4*)(rp + 8) = a2; *(f32x4*)(rp + 12) = a3;
        __syncthreads();
        if (F.tid < 256) {
            const int b = F.tid >> 6, c = F.tid & 63; float s2 = 0.f;
            for (int p = 0; p < 32; ++p) s2 += red[(p * 16 + (c >> 2)) * 16 + b * 4 + (c & 3)];
            F.ada[b * 6 * D + u * 64 + c] = s2 + F.b_ada[u * 64 + c];
        }
        __syncthreads();
    }
}

DEVINL void p_lnmod(Frame& F) {
    const int gw = F.bid * NWAVES + F.wave, NGW = F.G * NWAVES;
    for (int m = gw; m < NT; m += NGW) {
        const int b = m / S;
        const f32x4* xr = (const f32x4*)(F.x + (size_t)m * D) + F.lane;
        f32x4 v[8]; float s = 0.f;
#pragma unroll
        for (int j = 0; j < 8; ++j) { v[j] = xr[64 * j]; s += (v[j].x + v[j].y) + (v[j].z + v[j].w); }
        const float mean = wave_sum(s) * (1.f / D); float s2 = 0.f;
#pragma unroll
        for (int j = 0; j < 8; ++j) { v[j] = v[j] - mean; s2 += (v[j].x * v[j].x + v[j].y * v[j].y) + (v[j].z * v[j].z + v[j].w * v[j].w); }
        const float rstd = 1.f / sqrtf(wave_sum(s2) * (1.f / D) + EPS);
        const f32x4* sh = (const f32x4*)(F.ada + (size_t)b * 6 * D) + F.lane;
        const f32x4* scp = (const f32x4*)(F.ada + (size_t)b * 6 * D + D) + F.lane;
        f32x4* o = (f32x4*)(F.h + (size_t)m * D) + F.lane;
#pragma unroll
        for (int j = 0; j < 8; ++j) o[64 * j] = v[j] * rstd * (scp[64 * j] + 1.f) + sh[64 * j];
    }
}

DEVINL void p_post(Frame& F) {
    const int gw = F.bid * NWAVES + F.wave, NGW = F.G * NWAVES, lane = F.lane;
    for (int m = gw; m < NT; m += NGW) {
        float* p = F.proj + (size_t)m * INW;
        const float pos = (float)F.pos[m];
#pragma unroll
        for (int j = 0; j < 4; ++j) {
            const int id = lane + 64 * j, which = id >> 7, hd = (id >> 4) & 7, i = id & 15;
            float* q = p + (which ? O_AK : O_AQ) + hd * 128;
            float c, s; rope_cs(pos, i, 16, c, s);
            const float x1 = q[i], x2 = q[i + 16];
            q[i] = x1 * c - x2 * s; q[i + 16] = x2 * c + x1 * s;
        }
#pragma unroll
        for (int j = 0; j < 2; ++j) {
            const int id = lane + 64 * j, hd = id >> 3, i = id & 7;
            float* q = p + O_IQ + hd * 64;
            float c, s; rope_cs(pos, i, 8, c, s);
            const float x1 = q[i], x2 = q[i + 8];
            q[i] = x1 * c - x2 * s; q[i + 8] = x2 * c + x1 * s;
        }
        {
            const float v = p[O_IK + lane];
            const float mean = wave_sum(v) * (1.f / 64.f);
            const float d = v - mean;
            const float var = wave_sum(d * d) * (1.f / 64.f);
            float y = d * (1.f / sqrtf(var + EPS)) * F.ikg[lane] + F.ikb[lane];
            const float other = __shfl_xor(y, 8);
            float c, s; rope_cs(pos, lane & 7, 8, c, s);
            if (lane < 8) y = y * c - other * s; else if (lane < 16) y = y * c + other * s;
            p[O_IK + lane] = y;
        }
        {
            float v[8]; float ss = 0.f;
#pragma unroll
            for (int j = 0; j < 8; ++j) { v[j] = p[O_QD + lane + 64 * j]; ss += v[j] * v[j]; }
            const float r = 1.f / sqrtf(wave_sum(ss) * (1.f / 512.f) + EPS);
#pragma unroll
            for (int j = 0; j < 8; ++j) p[O_QD + lane + 64 * j] = v[j] * r * F.qng[lane + 64 * j];
        }
        {
            float v[4]; float ss = 0.f;
#pragma unroll
            for (int j = 0; j < 4; ++j) { v[j] = p[O_KVD + lane + 64 * j]; ss += v[j] * v[j]; }
            const float r = 1.f / sqrtf(wave_sum(ss) * (1.f / 256.f) + EPS);
#pragma unroll
            for (int j = 0; j < 4; ++j) p[O_KVD + lane + 64 * j] = v[j] * r * F.kvng[lane + 64 * j];
        }
        {
            float y = p[O_KR + lane];
            const float other = __shfl_xor(y, 32);
            float c, s; rope_cs(pos, lane & 31, 32, c, s);
            y = (lane < 32) ? (y * c - other * s) : (y * c + other * s);
            p[O_KR + lane] = y;
        }
    }
}

DEVINL void p_qrope(Frame& F) {
    const int gw = F.bid * NWAVES + F.wave, NGW = F.G * NWAVES, lane = F.lane;
    for (int m = gw; m < NT; m += NGW) {
        float* p = F.qb + (size_t)m * 1536;
        const float pos = (float)F.pos[m];
#pragma unroll
        for (int j = 0; j < 4; ++j) {
            const int id = lane + 64 * j, hd = id >> 5, i = id & 31;
            float* q = p + hd * 192 + 128;
            float c, s; rope_cs(pos, i, 32, c, s);
            const float x1 = q[i], x2 = q[i + 32];
            q[i] = x1 * c - x2 * s; q[i + 32] = x2 * c + x1 * s;
        }
    }
}

DEVINL unsigned f2key(float f) { const unsigned u = __builtin_bit_cast(unsigned, f + 0.0f); return (u & 0x80000000u) ? ~u : (u | 0x80000000u); }
DEVINL void p_index(Frame& F, float* lds) {
    float* iqs = lds;
    float* iws = lds + 1024;
    unsigned* key = (unsigned*)(lds + 1040);
    unsigned* hist = key + 4096;
    unsigned* misc = hist + 256;
    const int tid = F.tid;
    for (int q = F.bid; q < NT; q += F.G) {
        const int b = q / S, t = q % S, ci = t >> 6, n = (ci + 1) * 64;
        const float* pq = F.proj + (size_t)q * INW;
        __syncthreads();
        for (int i = tid; i < 1024; i += NTHREADS) iqs[i] = pq[O_IQ + i];
        if (tid < 16) iws[tid] = pq[O_IW + tid];
        __syncthreads();
        for (int s = tid; s < n; s += NTHREADS) {
            const f32x4* kp = (const f32x4*)(F.proj + (size_t)(b * S + s) * INW + O_IK);
            f32x4 kr[16];
#pragma unroll
            for (int j = 0; j < 16; ++j) kr[j] = kp[j];
            float sc = 0.f;
            for (int h = 0; h < 16; ++h) {
                const f32x4* qh = (const f32x4*)(iqs + h * 64);
                float d = 0.f;
#pragma unroll
                for (int j = 0; j < 16; ++j) { const f32x4 qq = qh[j]; d += qq.x * kr[j].x + qq.y * kr[j].y + qq.z * kr[j].z + qq.w * kr[j].w; }
                sc += iws[h] * fmaxf(d, 0.f);
            }
            key[s] = f2key(sc * INDEX_SCALE);
        }
        __syncthreads();
        unsigned T = 0u;
        if (n > 256) {
            unsigned prefix = 0u, remaining = 256u;
            for (int pass = 0; pass < 4; ++pass) {
                const int shift = 24 - 8 * pass;
                if (tid < 256) hist[tid] = 0u;
                __syncthreads();
                for (int s = tid; s < n; s += NTHREADS) {
                    const unsigned kx = key[s];
                    if (pass == 0 || (kx >> (shift + 8)) == (prefix >> (shift + 8))) atomicAdd(&hist[(kx >> shift) & 255u], 1u);
                }
                __syncthreads();
                if (tid == 0) {
                    unsigned cum = 0u; int bin = 255;
                    for (; bin > 0; --bin) { if (cum + hist[bin] >= remaining) break; cum += hist[bin]; }
                    misc[0] = prefix | ((unsigned)bin << shift); misc[1] = remaining - cum; misc[2] = hist[bin];
                }
                __syncthreads();
                prefix = misc[0]; remaining = misc[1];
                __syncthreads();
            }
            T = prefix;
            const unsigned ties = misc[2];
            if (ties > remaining) {
                if (tid == 0) { unsigned keep = remaining; for (int s = 0; s < n; ++s) if (key[s] == T) { if (keep > 0u) --keep; else key[s] = 0u; } }
                __syncthreads();
            }
        }
        u64* mrow = F.mask + (size_t)q * 64;
        for (int w = F.wave; w < 64; w += NWAVES) {
            bool sel = false;
            if (w <= ci) sel = key[w * 64 + F.lane] >= T;
            const u64 bits = __ballot(sel);
            if (F.lane == 0) mrow[w] = bits;
        }
    }
}

template <int DQ1, int DQ2, bool MASK>
DEVINL void attn_unit_f32(float* lds, const float* q1, size_t ldq1, const float* q2, size_t ldq2, const float* k1, size_t ldk1, const float* k2, size_t ldk2,
                          const float* v, size_t ldv, const u64* mask, float* out, size_t ldo, int ci, float scale) {
    constexpr int DQ = DQ1 + DQ2, LQ = DQ + 4, LV = 132, LP = 36;
    float* Qs = lds;
    float* Ks = Qs + 64 * LQ;
    float* Vs = Ks + 32 * LQ;
    float* Ps = Vs + 32 * LV;
    const int tid = threadIdx.x;
    const int tq = tid >> 3, tk = tid & 7;
    __syncthreads();
    for (int idx = tid; idx < 64 * (DQ / 4); idx += NTHREADS) {
        const int row = idx / (DQ / 4), c4 = idx % (DQ / 4);
        f32x4 val;
        if (c4 < DQ1 / 4) val = *(const f32x4*)(q1 + (size_t)row * ldq1 + 4 * c4);
        else val = *(const f32x4*)(q2 + (size_t)row * ldq2 + 4 * (c4 - DQ1 / 4));
        *(f32x4*)(Qs + row * LQ + 4 * c4) = val;
    }
    float m = -1e30f, l = 0.f;
    f32x4 o[4];
#pragma unroll
    for (int i = 0; i < 4; ++i) o[i] = (f32x4){0.f, 0.f, 0.f, 0.f};
    const int ntiles = (ci + 1) * 2;
    for (int kt = 0; kt < ntiles; ++kt) {
        __syncthreads();
        for (int idx = tid; idx < 32 * (DQ / 4); idx += NTHREADS) {
            const int row = idx / (DQ / 4), c4 = idx % (DQ / 4); const size_t key = (size_t)kt * 32 + row;
            f32x4 val;
            if (c4 < DQ1 / 4) val = *(const f32x4*)(k1 + key * ldk1 + 4 * c4);
            else val = *(const f32x4*)(k2 + key * ldk2 + 4 * (c4 - DQ1 / 4));
            *(f32x4*)(Ks + row * LQ + 4 * c4) = val;
        }
        for (int idx = tid; idx < 32 * 32; idx += NTHREADS) {
            const int row = idx >> 5, c4 = idx & 31; const size_t key = (size_t)kt * 32 + row;
            *(f32x4*)(Vs + row * LV + 4 * c4) = *(const f32x4*)(v + key * ldv + 4 * c4);
        }
        __syncthreads();
        float s[4] = {0.f, 0.f, 0.f, 0.f};
        for (int d = 0; d < DQ; d += 4) {
            const f32x4 qq = *(const f32x4*)(Qs + tq * LQ + d);
#pragma unroll
            for (int j = 0; j < 4; ++j) { const f32x4 kk = *(const f32x4*)(Ks + (4 * tk + j) * LQ + d); s[j] += qq.x * kk.x + qq.y * kk.y + qq.z * kk.z + qq.w * kk.w; }
        }
        unsigned mbits = 0xFu;
        if (MASK) { const u64 w = mask[(size_t)tq * 64 + (kt >> 1)]; mbits = (unsigned)(w >> ((kt & 1) * 32 + 4 * tk)) & 0xFu; }
        float mx = -INFINITY;
#pragma unroll
        for (int j = 0; j < 4; ++j) { s[j] = ((mbits >> j) & 1u) ? s[j] * scale : -INFINITY; mx = fmaxf(mx, s[j]); }
        mx = fmaxf(mx, __shfl_xor(mx, 1)); mx = fmaxf(mx, __shfl_xor(mx, 2)); mx = fmaxf(mx, __shfl_xor(mx, 4));
        const float mn = fmaxf(m, mx), alpha = expf(m - mn);
        float ps = 0.f;
#pragma unroll
        for (int j = 0; j < 4; ++j) { const float p = expf(s[j] - mn); ps += p; Ps[tq * LP + 4 * tk + j] = p; }
        ps += __shfl_xor(ps, 1); ps += __shfl_xor(ps, 2); ps += __shfl_xor(ps, 4);
        l = l * alpha + ps; m = mn;
#pragma unroll
        for (int i = 0; i < 4; ++i) o[i] = o[i] * alpha;
        __syncthreads();
        for (int k = 0; k < 32; ++k) {
            const float p = Ps[tq * LP + k];
#pragma unroll
            for (int i = 0; i < 4; ++i) { const f32x4 vv = *(const f32x4*)(Vs + k * LV + 4 * (tk + 8 * i)); o[i] = o[i] + vv * p; }
        }
    }
    const float inv = 1.f / l;
#pragma unroll
    for (int i = 0; i < 4; ++i) *(f32x4*)(out + (size_t)tq * ldo + 4 * (tk + 8 * i)) = o[i] * inv;
}

DEVINL void p_attn(Frame& F, float* lds) {
    for (int u = F.bid; u < 4096; u += F.G) {
        const int kind = u >> 11, r = u & 2047, ci = 63 - (r >> 5), bh = r & 31, b = bh >> 3, hd = bh & 7;
        const size_t t0 = (size_t)b * S + (size_t)ci * 64, tb = (size_t)b * S;
        if (kind == 0) {
            attn_unit_f32<128, 0, true>(lds, F.proj + t0 * INW + O_AQ + hd * 128, INW, nullptr, 0, F.proj + tb * INW + O_AK + hd * 128, INW, nullptr, 0,
                                         F.proj + tb * INW + O_AV + hd * 128, INW, F.mask + t0 * 64, F.oab + t0 * D + hd * 128, D, ci, 0.08838834764831845f);
        } else {
            attn_unit_f32<128, 64, false>(lds, F.qb + t0 * 1536 + hd * 192, 1536, F.qb + t0 * 1536 + hd * 192 + 128, 1536, F.kv + tb * D + hd * 256, D, F.proj + tb * INW + O_KR, INW,
                                          F.kv + tb * D + hd * 256 + 128, D, nullptr, F.oab + t0 * D + 1024 + hd * 128, D, ci, 0.07216878364870322f);
        }
    }
}

DEVINL void p_merge(Frame& F) {
    const int gw = F.bid * NWAVES + F.wave, NGW = F.G * NWAVES;
    for (int m = gw; m < NT; m += NGW) {
#pragma unroll
        for (int half = 0; half < 2; ++half) {
            f32x4* p = (f32x4*)(F.oab + (size_t)m * D + half * 1024) + F.lane;
            const f32x4* g = (const f32x4*)(half ? F.onbg : F.onag) + F.lane;
            f32x4 v[4]; float ss = 0.f;
#pragma unroll
            for (int j = 0; j < 4; ++j) { v[j] = p[64 * j]; ss += (v[j].x * v[j].x + v[j].y * v[j].y) + (v[j].z * v[j].z + v[j].w * v[j].w); }
            const float r = 1.f / sqrtf(wave_sum(ss) * (1.f / 1024.f) + EPS);
#pragma unroll
            for (int j = 0; j < 4; ++j) p[64 * j] = v[j] * r * g[64 * j];
        }
    }
}

DEVINL void p_router(Frame& F, float* lds) {
    const int gw = F.bid * NWAVES + F.wave, NGW = F.G * NWAVES, lane = F.lane;
    for (int m = gw; m < NT; m += NGW) {
        const int b = m / S;
        f32x4* xr = (f32x4*)(F.x1 + (size_t)m * D) + lane;
        f32x4 v[8]; float s = 0.f;
#pragma unroll
        for (int j = 0; j < 8; ++j) { v[j] = xr[64 * j]; s += (v[j].x + v[j].y) + (v[j].z + v[j].w); }
        float mean = wave_sum(s) * (1.f / D); float s2 = 0.f;
#pragma unroll
        for (int j = 0; j < 8; ++j) { v[j] = v[j] - mean; s2 += (v[j].x * v[j].x + v[j].y * v[j].y) + (v[j].z * v[j].z + v[j].w * v[j].w); }
        float rstd = 1.f / sqrtf(wave_sum(s2) * (1.f / D) + EPS);
        const f32x4* g = (const f32x4*)F.lnmg + lane; const f32x4* bb = (const f32x4*)F.lnmb + lane;
        s = 0.f;
#pragma unroll
        for (int j = 0; j < 8; ++j) { v[j] = v[j] * rstd * g[64 * j] + bb[64 * j]; xr[64 * j] = v[j]; s += (v[j].x + v[j].y) + (v[j].z + v[j].w); }
        mean = wave_sum(s) * (1.f / D); s2 = 0.f;
#pragma unroll
        for (int j = 0; j < 8; ++j) { v[j] = v[j] - mean; s2 += (v[j].x * v[j].x + v[j].y * v[j].y) + (v[j].z * v[j].z + v[j].w * v[j].w); }
        rstd = 1.f / sqrtf(wave_sum(s2) * (1.f / D) + EPS);
        const f32x4* sh = (const f32x4*)(F.ada + (size_t)b * 6 * D + 3 * D) + lane;
        const f32x4* scp = (const f32x4*)(F.ada + (size_t)b * 6 * D + 4 * D) + lane;
        u32x2* ho = (u32x2*)(F.hA + (size_t)m * D) + lane; f32x4* hf = (f32x4*)(F.h + (size_t)m * D) + lane;
#pragma unroll
        for (int j = 0; j < 8; ++j) { v[j] = v[j] * rstd * (scp[64 * j] + 1.f) + sh[64 * j]; ho[64 * j] = (u32x2){pk_f16(v[j].x, v[j].y), pk_f16(v[j].z, v[j].w)}; hf[64 * j] = v[j]; }
        float* hs = lds + F.wave * D;
#pragma unroll
        for (int j = 0; j < 8; ++j) *(f32x4*)(hs + 4 * lane + 256 * j) = v[j];
        float part[32];
#pragma unroll
        for (int e = 0; e < 32; ++e) part[e] = 0.f;
#pragma unroll 1
        for (int i = 0; i < 32; ++i) {
            const int k = 4 * lane + 256 * (i >> 2) + (i & 3); const float hv = hs[k];
            const f32x4* wr = (const f32x4*)(F.w_router + (size_t)k * 32);
#pragma unroll
            for (int e4 = 0; e4 < 8; ++e4) { const f32x4 w = wr[e4]; part[4 * e4] += hv * w.x; part[4 * e4 + 1] += hv * w.y; part[4 * e4 + 2] += hv * w.z; part[4 * e4 + 3] += hv * w.w; }
        }
        float myv = -INFINITY;
#pragma unroll
        for (int e = 0; e < 32; ++e) { const float tot = wave_sum(part[e]); if (lane == e) myv = tot + F.b_router[e]; }
        int se[4]; float sv[4];
#pragma unroll
        for (int k = 0; k < 4; ++k) {
            float bv = myv; int bi = lane;
#pragma unroll
            for (int o = 1; o < 64; o <<= 1) { const float ov = __shfl_xor(bv, o); const int oi = __shfl_xor(bi, o); if (ov > bv || (ov == bv && oi < bi)) { bv = ov; bi = oi; } }
            se[k] = bi; sv[k] = bv; if (lane == bi) myv = -INFINITY;
        }
        const float e0 = 1.f, e1 = expf(sv[1] - sv[0]), e2 = expf(sv[2] - sv[0]), e3 = expf(sv[3] - sv[0]);
        const float inv = 1.f / (e0 + e1 + e2 + e3);
        if (lane < 4) {
            const int e = lane == 0 ? se[0] : lane == 1 ? se[1] : lane == 2 ? se[2] : se[3];
            const float gv = (lane == 0 ? e0 : lane == 1 ? e1 : lane == 2 ? e2 : e3) * inv;
            const unsigned p = atomicAdd(F.ctl + CW_CNT + e, 1u);
            F.list[(size_t)e * LISTCAP + p] = m * 4 + lane;
            F.tope[m * 4 + lane] = e; F.gate[m * 4 + lane] = gv;
        }
    }
}

struct MoeTab { int cnt[NE], tstart[NE + 1], offs[NE + 1]; };
DEVINL void moe_tab(Frame& F, MoeTab* tb) {
    __syncthreads();
    if (F.tid == 0) {
        int ts = 0, of = 0;
        for (int e = 0; e < NE; ++e) { const int c = (int)__hip_atomic_load(F.ctl + CW_CNT + e, __ATOMIC_RELAXED, __HIP_MEMORY_SCOPE_AGENT); tb->cnt[e] = c; tb->tstart[e] = ts; tb->offs[e] = of; ts += (c + 127) / 128; of += c; }
        tb->tstart[NE] = ts; tb->offs[NE] = of;
    }
    __syncthreads();
}
struct RowGatherH { const float* h; const int* lst; int r0, cnt; DEVINL const float* operator()(int r) const { int rr = r0 + r; rr = rr < cnt ? rr : cnt - 1; return h + (size_t)(lst[rr] >> 2) * D; } };
struct RowAct { const float* act; int base, r0, cnt; DEVINL const float* operator()(int r) const { int rr = r0 + r; rr = rr < cnt ? rr : cnt - 1; return act + (size_t)(base + rr) * DFF; } };

DEVINL void p_final(Frame& F) {
    const int gw = F.bid * NWAVES + F.wave, NGW = F.G * NWAVES, lane = F.lane;
    for (int m = gw; m < NT; m += NGW) {
        const int b = m / S;
        const f32x4* xr = (const f32x4*)(F.x1 + (size_t)m * D) + lane;
        const f32x4* g2 = (const f32x4*)(F.ada + (size_t)b * 6 * D + 5 * D) + lane;
        const f32x4* y0 = (const f32x4*)(F.y + (size_t)m * 4 * D) + lane;
        f32x4 v[8]; float s = 0.f;
#pragma unroll
        for (int j = 0; j < 8; ++j) {
            const f32x4 ys = ((y0[64 * j] + y0[512 + 64 * j]) + y0[1024 + 64 * j]) + y0[1536 + 64 * j];
            v[j] = xr[64 * j] * ALPHA + g2[64 * j] * ys; s += (v[j].x + v[j].y) + (v[j].z + v[j].w);
        }
        const float mean = wave_sum(s) * (1.f / D); float s2 = 0.f;
#pragma unroll
        for (int j = 0; j < 8; ++j) { v[j] = v[j] - mean; s2 += (v[j].x * v[j].x + v[j].y * v[j].y) + (v[j].z * v[j].z + v[j].w * v[j].w); }
        const float rstd = 1.f / sqrtf(wave_sum(s2) * (1.f / D) + EPS);
        const f32x4* g = (const f32x4*)F.lnfg + lane; const f32x4* bb = (const f32x4*)F.lnfb + lane;
        f32x4* o = (f32x4*)(F.out + (size_t)m * D) + lane;
#pragma unroll
        for (int j = 0; j < 8; ++j) o[64 * j] = v[j] * rstd * g[64 * j] + bb[64 * j];
    }
}

struct EpiStore { float* C; size_t ldc; int m0, N; DEVINL void operator()(int row, int col, float v) const { if (col < N) C[(size_t)(m0 + row) * ldc + col] = v; } };
struct EpiPre { float* C; const float* x; const float* g1; int m0; DEVINL void operator()(int row, int col, float v) const { const size_t i = (size_t)(m0 + row) * D + col; C[i] = ALPHA * x[i] + g1[col] * v; } };
struct EpiGU { float* act; const float* bias; int base, r0, cnt, lane; DEVINL void operator()(int row, int col, float v) const {
        const float t = v + bias[col]; const float o = __shfl_xor(t, 1);
        if (!(lane & 1) && r0 + row < cnt) { float g = fminf(t, 7.0f); float u = fminf(fmaxf(o, -7.0f), 7.0f); const float sg = 1.f / (1.f + expf(-1.702f * g)); act[(size_t)(base + r0 + row) * DFF + (col >> 1)] = (u + 1.f) * (g * sg); } } };
struct EpiDown { float* y; const float* bias; const int* lst; const float* gate; int r0, cnt; DEVINL void operator()(int row, int col, float v) const {
        if (r0 + row < cnt) { const int aid = lst[r0 + row]; y[(size_t)aid * D + col] = (v + bias[col]) * gate[aid]; } } };


DEVINL int permA(int d) { return 8 * ((d & 15) >> 2) + 4 * (d >> 4) + (d & 3); }
DEVINL int permI(int d) { return d < 16 ? 8 * ((d & 7) >> 2) + 4 * (d >> 3) + (d & 3) : 8 * (2 + (((d - 16) & 7) >> 2)) + 4 * ((d - 16) >> 3) + (d & 3); }
DEVINL int permR(int d) { const int n = d >> 5, r = d & 31; return 32 * (r >> 4) + 8 * ((r & 15) >> 2) + 4 * n + (r & 3); }
DEVINL int vcol_in(int p) {
    if (p < 2048) { const int d = p & 127; return (p & ~127) + (d < 32 ? permA(d) : d); }
    if (p < 3072) return p;
    if (p < 4096) { const int d = p & 63; return (p & ~63) + (d < 32 ? permI(d) : d); }
    if (p < 4160) { const int d = p - 4096; return d < 32 ? V_IK_LO + permI(d) : V_IK_HI + (d - 32); }
    if (p < 4176) return V_IW + (p - 4160);
    if (p < 4688) return V_QD + (p - 4176);
    if (p < 4944) return V_KVD + (p - 4688);
    return V_KR + permR(p - 4944);
}
#define LDS_WAIT() asm volatile("s_waitcnt lgkmcnt(0)" ::: "memory")

template <class Map>
DEVINL void transpose_item(const float* __restrict__ W, int N, f16* __restrict__ WT, int ldt, const float* __restrict__ kscale, const Map& map, LAS float* scr, int item, int lane) {
    const int nblk = (N + 63) / 64, kb = item / nblk, nb = item % nblk, k0 = 64 * kb, n0 = 64 * nb;
    f32x4 v[16];
    const int n4 = (lane & 15) * 4;
#pragma unroll
    for (int i = 0; i < 16; ++i) {
        const int k = 4 * i + (lane >> 4);
        v[i] = (f32x4){0.f, 0.f, 0.f, 0.f};
        if (n0 + n4 < N) v[i] = *(const f32x4*)(W + (size_t)(k0 + k) * N + n0 + n4);
    }
#pragma unroll
    for (int i = 0; i < 16; ++i) {
        const int k = 4 * i + (lane >> 4);
        if (kscale) v[i] = v[i] * kscale[k0 + k];
        scr[k * 65 + n4] = v[i].x; scr[k * 65 + n4 + 1] = v[i].y; scr[k * 65 + n4 + 2] = v[i].z; scr[k * 65 + n4 + 3] = v[i].w;
    }
    LDS_WAIT();
    const int c = lane & 7;
#pragma unroll
    for (int j = 0; j < 8; ++j) {
        const int n = (lane >> 3) + 8 * j;
        const int dr = (n0 + n < N) ? map(n0 + n) : -1;
        const LAS float* sp = scr + (8 * c) * 65 + n;
        u32x4 o; o.x = pk_f16(sp[0], sp[65]); o.y = pk_f16(sp[2 * 65], sp[3 * 65]); o.z = pk_f16(sp[4 * 65], sp[5 * 65]); o.w = pk_f16(sp[6 * 65], sp[7 * 65]);
        if (dr >= 0) *(u32x4*)(WT + (size_t)dr * ldt + k0 + 8 * c) = o;
    }
    LDS_WAIT();
}

constexpr float W8_SCALE = 64.f, W8_INV = 1.f / 64.f;
DEVINL unsigned pk4_fp8(float a, float b, float c, float d) { int p = __builtin_amdgcn_cvt_pk_fp8_f32(a, b, 0, false); p = __builtin_amdgcn_cvt_pk_fp8_f32(c, d, p, true); return (unsigned)p; }
DEVINL void ti8_load(const float* __restrict__ W, int N, int item, int lane, f32x4 (&v)[16]) {
    const int nblk = N / 32, kb = item / nblk, nb = item % nblk, k0 = 128 * kb, n0 = 32 * nb, n4 = (lane & 7) * 4;
#pragma unroll
    for (int i = 0; i < 16; ++i) { const int k = 8 * i + (lane >> 3); v[i] = __builtin_nontemporal_load((const f32x4*)(W + (size_t)(k0 + k) * N + n0 + n4)); }
}
DEVINL void ti8_put(const f32x4 (&v)[16], LAS float* scr, int lane, const float* __restrict__ kscale = nullptr, int k0 = 0) {
    LAS unsigned* wp = (LAS unsigned*)scr + (lane & 7) * 136 + (lane >> 3);
#pragma unroll
    for (int i = 0; i < 16; ++i) { const float sc = kscale ? W8_SCALE * kscale[k0 + 8 * i + (lane >> 3)] : W8_SCALE; wp[8 * i] = pk4_fp8(v[i].x * sc, v[i].y * sc, v[i].z * sc, v[i].w * sc); }
    LDS_WAIT();
}
template <class RowOf>
DEVINL void ti8_flush8(unsigned char* WT, int ldt, int kb, int n0, const RowOf& rowof, LAS float* scr, int lane) {
    const int gl = lane >> 4, c = lane & 15;
#pragma unroll
    for (int p = 0; p < 2; ++p) {
        const int g = 4 * p + gl;
        const LAS u32x4* sp = (const LAS u32x4*)((LAS unsigned*)scr + g * 136 + 8 * c);
        const u32x4 q0 = sp[0], q1 = sp[1];
        const unsigned x0 = __builtin_amdgcn_perm(q0.y, q0.x, 0x05010400u), x1 = __builtin_amdgcn_perm(q0.y, q0.x, 0x07030602u), y0 = __builtin_amdgcn_perm(q0.w, q0.z, 0x05010400u), y1 = __builtin_amdgcn_perm(q0.w, q0.z, 0x07030602u);
        const unsigned z0 = __builtin_amdgcn_perm(q1.y, q1.x, 0x05010400u), z1 = __builtin_amdgcn_perm(q1.y, q1.x, 0x07030602u), w0 = __builtin_amdgcn_perm(q1.w, q1.z, 0x05010400u), w1 = __builtin_amdgcn_perm(q1.w, q1.z, 0x07030602u);
        const u32x2 o0 = {__builtin_amdgcn_perm(y0, x0, 0x05040100u), __builtin_amdgcn_perm(w0, z0, 0x05040100u)}, o1 = {__builtin_amdgcn_perm(y0, x0, 0x07060302u), __builtin_amdgcn_perm(w0, z0, 0x07060302u)};
        const u32x2 o2 = {__builtin_amdgcn_perm(y1, x1, 0x05040100u), __builtin_amdgcn_perm(w1, z1, 0x05040100u)}, o3 = {__builtin_amdgcn_perm(y1, x1, 0x07060302u), __builtin_amdgcn_perm(w1, z1, 0x07060302u)};
        typedef __attribute__((address_space(1))) u32x2 gu32x2;
        const int nn = n0 + 4 * g;
        auto at = [&](int row) { return WT + ((size_t)(row >> 8) * (ldt >> 7) + kb) * 32768 + (row & 255) * 128 + 8 * c; };
        __builtin_nontemporal_store(o0, (gu32x2*)at(rowof(nn))); __builtin_nontemporal_store(o1, (gu32x2*)at(rowof(nn + 1))); __builtin_nontemporal_store(o2, (gu32x2*)at(rowof(nn + 2))); __builtin_nontemporal_store(o3, (gu32x2*)at(rowof(nn + 3)));
    }
    LDS_WAIT();
}
struct MapIn { DEVINL int operator()(int n) const { return vcol_in(n); } };
struct MapId { DEVINL int operator()(int n) const { return n; } };
struct MapQup { DEVINL int operator()(int n) const { const int h = n / 192, d = n - h * 192; return h * 192 + (d < 128 ? d : 128 + permR(d - 128)); } };
struct MapGU { DEVINL int operator()(int n) const { const int j = n >> 1; return 256 * (j >> 7) + (j & 127) + 128 * (n & 1); } };

DEVINL void p_moeconv(Frame& F, float* lds, int gw_, int NGW, int first = 0, int cnt = 1 << 30) {
    const int gw = __builtin_amdgcn_readfirstlane(gw_) + first * NGW;
    LAS float* scr = (LAS float*)lds + F.wave * 4352;
    const int lane = F.lane;
    constexpr int I_GU = (D / 128) * (2 * DFF / 32), I_DN = (DFF / 128) * (D / 32), I_E = I_GU + I_DN, I_MOE = NE * I_E;
    if (gw >= I_MOE) return;
    const int nall = (I_MOE - gw + NGW - 1) / NGW, nsteps = nall < cnt ? nall : cnt, n3 = (nsteps + 2) / 3 * 3;
    const float* const w_gu = F.w_gu; const float* const w_dn = F.w_dn; unsigned char* const WguT = (unsigned char*)F.WguT; unsigned char* const WdT = (unsigned char*)F.WdT;
    auto load = [&](f32x4 (&v)[16], int step, int lo, int hi) {
        const int it = gw + (step < nsteps ? step : nsteps - 1) * NGW, e = it / I_E, r = it - e * I_E;
        const bool gu = r < I_GU;
        const float* W = gu ? w_gu + (size_t)e * D * 2 * DFF : w_dn + (size_t)e * DFF * D;
        const int N = gu ? 2 * DFF : D, sh = gu ? 7 : 6, il = gu ? r : r - I_GU, kb = il >> sh, nb = il - (kb << sh);
        const unsigned long long wa = (unsigned long long)W;
        const u32x4 rs = {(unsigned)__builtin_amdgcn_readfirstlane((int)(unsigned)wa), (unsigned)__builtin_amdgcn_readfirstlane((int)(unsigned)(wa >> 32)) & 0xffffu, 0xffffffffu, 0x00020000u};
        const int vo = ((lane >> 3) * N + (lane & 7) * 4) * 4, so = (128 * kb * N + 32 * nb) * 4;
#pragma unroll
        for (int i = lo; i < hi; ++i) { const int soi = __builtin_amdgcn_readfirstlane(so + 8 * i * N * 4); asm volatile("buffer_load_dwordx4 %0, %1, %2, %3 offen nt" : "=v"(v[i]) : "v"(vo), "s"(rs), "s"(soi) : "memory"); }
    };
    auto flush = [&](int step) {
        const int it = gw + (step < nsteps ? step : nsteps - 1) * NGW, e = it / I_E, r = it - e * I_E;
        const bool gu = r < I_GU;
        unsigned char* WT = gu ? WguT + (size_t)e * 2 * DFF * D : WdT + (size_t)e * D * DFF;
        const int ldt = gu ? D : DFF, sh = gu ? 7 : 6, il = gu ? r : r - I_GU, kb = il >> sh, nb = il - (kb << sh);
        ti8_flush8(WT, ldt, kb, 32 * nb, [gu](int nn) { return gu ? MapGU()(nn) : nn; }, scr, lane);
    };
#define MOE_WAIT(v_, n_) asm volatile("s_waitcnt vmcnt(" #n_ ")" : "+v"(v_[0]), "+v"(v_[1]), "+v"(v_[2]), "+v"(v_[3]), "+v"(v_[4]), "+v"(v_[5]), "+v"(v_[6]), "+v"(v_[7]), \
        "+v"(v_[8]), "+v"(v_[9]), "+v"(v_[10]), "+v"(v_[11]), "+v"(v_[12]), "+v"(v_[13]), "+v"(v_[14]), "+v"(v_[15]) :: "memory")
#define MOE_STEP(vcur_, vnxt_, st_) do { load(vnxt_, (st_) + 2, 0, 8); MOE_WAIT(vcur_, 40); ti8_put(vcur_, scr, lane); __builtin_amdgcn_sched_barrier(0); \
        load(vnxt_, (st_) + 2, 8, 16); __builtin_amdgcn_sched_barrier(0); flush(st_); } while (0)
    f32x4 va[16], vb[16], vc[16];
    load(va, 0, 0, 16); load(vb, 1, 0, 16);
    MOE_WAIT(va, 0); MOE_WAIT(vb, 0);
#pragma unroll 1
    for (int st = 0; st < n3; st += 3) { MOE_STEP(va, vc, st); MOE_STEP(vb, va, st + 1); MOE_STEP(vc, vb, st + 2); }
#undef MOE_STEP
#undef MOE_WAIT
    asm volatile("s_waitcnt vmcnt(0)" ::: "memory");
}

DEVINL void p_prologue(Frame& F, float* lds, int gw, int NGW) {
    LAS float* scr = (LAS float*)lds + F.wave * 4352;
    const int lane = F.lane;
    constexpr int I_IN = (D / 64) * ((INW + 63) / 64);
    for (int it = gw; it < I_IN; it += NGW) transpose_item(F.w_in, INW, F.WinT, D, nullptr, MapIn(), scr, it, lane);
    {
        constexpr int I_OUT = (D / 64) * (D / 64), I_GU = (D / 128) * (2 * DFF / 32), I_DN = (DFF / 128) * (D / 32), I_MOE = NE * (I_GU + I_DN);
#if OUTPROJ_F8
        for (int it = gw; it < (D / 128) * (D / 32); it += NGW) {
            f32x4 vo[16]; ti8_load(F.w_out, D, it, lane, vo);
            const int k0 = 128 * (it / (D / 32));
            ti8_put(vo, scr, lane, k0 < 1024 ? F.onag : F.onbg - 1024, k0); ti8_flush8((unsigned char*)F.WoutT, D, k0 >> 7, 32 * (it % (D / 32)), MapId(), scr, lane);
        }
#else
        for (int it = gw; it < I_OUT; it += NGW) { const int k0 = 64 * (it / (D / 64)); transpose_item(F.w_out, D, F.WoutT, D, k0 < 1024 ? F.onag : F.onbg - 1024, MapId(), scr, it, lane); }
#endif
        for (int i = gw * 64 + lane; i < NE * 2 * DFF; i += NGW * 64) { const int e = i >> 12, v = i & 4095, t = v >> 8, w = v & 255; F.bguP[i] = F.b_gu[(size_t)e * 2 * DFF + 2 * (128 * t + (w & 127)) + (w >> 7)]; }
    }
    {   constexpr int I_QU = (512 / 64) * (1536 / 64), I_KV = (256 / 64) * (2048 / 64);
        for (int it = gw; it < I_QU + I_KV; it += NGW) {
            if (it < I_QU) transpose_item(F.w_q_up, 1536, F.WqupT, 512, F.qng, MapQup(), scr, it, lane);
            else transpose_item(F.w_kv_up, 2048, F.WkvupT, 256, F.kvng, MapId(), scr, it - I_QU, lane);
        }
    }
    for (int i = gw * 64 + lane; i < NE * D; i += NGW * 64) { const int e = i >> 11, k = i & 2047; F.WrT[i] = (f16)F.w_router[(size_t)k * NE + e]; }
    if (gw == 0) { const int v = lane < 32 ? permI(lane) : lane; F.ikv[v] = F.ikg[lane]; F.ikv[64 + v] = F.ikb[lane]; }
    for (int i = gw * 64 + lane; i < 16 * D / 8; i += NGW * 64) ((u32x4*)(F.WinT + (size_t)4912 * D))[i] = (u32x4){0u, 0u, 0u, 0u};
    for (int i = gw * 64 + lane; i < (NV - 5024) * D / 8; i += NGW * 64) ((u32x4*)(F.WinT + (size_t)5024 * D))[i] = (u32x4){0u, 0u, 0u, 0u};
    if (F.tid == 0) { unsigned sp_ = 0u; while (__hip_atomic_load(F.ctl + CW_ADA, __ATOMIC_RELAXED, __HIP_MEMORY_SCOPE_AGENT) < (unsigned)F.G) { __builtin_amdgcn_s_sleep(1); if (++sp_ > (1u << 22)) break; }
        __builtin_amdgcn_fence(__ATOMIC_ACQUIRE, "agent"); asm volatile("s_waitcnt vmcnt(0)" ::: "memory"); }
    __syncthreads();
    for (int m = gw; m < NT; m += NGW) {
        const int b = m / S;
        const f32x4* xr = (const f32x4*)(F.x + (size_t)m * D) + lane;
        f32x4 v[8]; float s = 0.f;
#pragma unroll
        for (int j = 0; j < 8; ++j) { v[j] = xr[64 * j]; s += (v[j].x + v[j].y) + (v[j].z + v[j].w); }
        const float mean = wave_sum(s) * (1.f / D); float s2 = 0.f;
#pragma unroll
        for (int j = 0; j < 8; ++j) { v[j] = v[j] - mean; s2 += (v[j].x * v[j].x + v[j].y * v[j].y) + (v[j].z * v[j].z + v[j].w * v[j].w); }
        const float rstd = 1.f / sqrtf(wave_sum(s2) * (1.f / D) + EPS);
        const f32x4* sh = (const f32x4*)(F.ada + (size_t)b * 6 * D) + lane;
        const f32x4* scp = (const f32x4*)(F.ada + (size_t)b * 6 * D + D) + lane;
        u32x2* o = (u32x2*)(F.hA + (size_t)m * D) + lane;
#pragma unroll
        for (int j = 0; j < 8; ++j) { const f32x4 y = v[j] * rstd * (scp[64 * j] + 1.f) + sh[64 * j]; o[64 * j] = (u32x2){pk_f16(y.x, y.y), pk_f16(y.z, y.w)}; }
        if (lane < 56) {
            const float pos = (float)F.pos[m];
            int i, half, oc, os;
            if (lane < 16) { i = lane; half = 16; oc = T_CA; os = T_SA; } else if (lane < 24) { i = lane - 16; half = 8; oc = T_CI; os = T_SI; } else { i = lane - 24; half = 32; oc = T_CR; os = T_SR; }
            float c, sn; rope_cs(pos, i, half, c, sn);
            F.tab[(size_t)m * TABW + oc + i] = c; F.tab[(size_t)m * TABW + os + i] = sn;
        }
    }
}

namespace g16 {
constexpr int BM = 256, BK = 64, HALF = 128, HTB = HALF * BK * 2, STAGE_BYTES = 8 * HTB, NXCD = 8, WGM = 8;
DEVINL int lds_byte(int r, int c) { const int st = (r >> 4) * 2 + (c >> 5), rr = r & 15, cc = c & 31, ob = rr * 64 + cc * 2; return st * 1024 + (ob ^ (((ob >> 9) & 1) << 5)); }
DEVINL void stage_rc(int b, int& R, int& C) { const int st = b / 1024, sb = b % 1024, swz = sb ^ (((sb >> 9) & 1) << 5); R = (st >> 1) * 16 + swz / 64; C = (st & 1) * 32 + (swz % 64) / 2; }
DEVINL int perm32(int rho) { const int n = rho >> 4, i = rho & 15; return 8 * (i >> 2) + 4 * n + (i & 3); }
struct Unit { int pm, pn, aux; };
struct Gemm { const f16* A; const f16* Bt; int lda, ldb, K; int btiled = 0; };
struct StaticOrder {
    static constexpr bool GATHER = false;
    int nM, nN, nwg, G, c, wgm;
    DEVINL void init(int M, int N, int G_, int c_, int wgm_ = WGM) { nM = M / BM; nN = N / BM; nwg = nM * nN; G = G_; c = c_; wgm = wgm_; }
    DEVINL bool next(int i, Unit& u) const {
        const long L = (long)i * G + c; if (L >= nwg) return false;
        int wgid = (int)L; { const int q = nwg / NXCD, r = nwg % NXCD, xcd = wgid % NXCD, off = wgid / NXCD; wgid = (xcd < r ? xcd * (q + 1) : r * (q + 1) + (xcd - r) * q) + off; }
        const int nig = wgm * nN, gid = wgid / nig, fm = gid * wgm, gsz = (nM - fm) < wgm ? (nM - fm) : wgm;
        u.pm = fm + ((wgid % nig) % gsz); u.pn = (wgid % nig) / gsz; u.aux = 0; return true;
    }
    DEVINL int arow(const Unit&, int) const { return 0; }
};
typedef int i32x8 __attribute__((ext_vector_type(8)));
template <class Epi, class Sched, bool ALIGN_EPI = true, bool F8 = false>
DEVINL void gemm_phase(LAS unsigned char* lds, const Gemm g, const Sched& S, const Epi& E) {
    int tid_ = threadIdx.x; asm volatile("" : "+v"(tid_));
    const int tid = tid_, wid = __builtin_amdgcn_readfirstlane(tid >> 6), lane = tid & 63, wr = wid >> 2, wc = wid & 3, fr = lane & 15, fq = lane >> 4;
    const int K = g.K, nt = K / BK;
    constexpr bool GA = Sched::GATHER;
    int RA[2], CA[2];
    unsigned voffB[2], offA[2][2], offAn[2][2];
#pragma unroll
    for (int i = 0; i < 2; ++i) { int R, C; stage_rc(tid * 16 + i * 8192, R, C); const int Rb = Epi::PERM ? ((R & ~31) + perm32(R & 31)) : R;
        RA[i] = R; CA[i] = C; voffB[i] = (unsigned)(Rb * (g.btiled ? BK : g.ldb) + C) * 2u;
        offA[0][i] = (unsigned)(R * g.lda + C) * 2u; offA[1][i] = (unsigned)((R + HALF) * g.lda + C) * 2u; offAn[0][i] = offA[0][i]; offAn[1][i] = offA[1][i]; }
    const size_t kstep = (size_t)(BK * 2);
    const size_t kstepB = g.btiled ? (size_t)(BM * BK * 2) : kstep, hstepB = g.btiled ? (size_t)(HALF * BK * 2) : (size_t)HALF * g.ldb * 2, tstepB = (size_t)BM * g.ldb * 2, tstepA = (size_t)BM * g.lda * 2;
    const unsigned ldsw = (unsigned)wid * 1024u;
    const int aoff = lds_byte(wr * 64 + fr, fq * 8), boff = lds_byte(wc * 32 + fr, fq * 8);
#define PG8_SA(b, h) (((b) * 2 + (h)) * HTB)
#define PG8_SB(b, h) ((4 + (b) * 2 + (h)) * HTB)
    const auto rsA = __builtin_amdgcn_make_buffer_rsrc((void*)g.A, 0, -1, 0x00020000), rsB = __builtin_amdgcn_make_buffer_rsrc((void*)g.Bt, 0, -1, 0x00020000);
#define PG8_STAGE_X(bufoff, rs, base0, gbase, voff) do { const int so_ = (int)(unsigned)((const char*)(gbase) - (const char*)(base0)); _Pragma("unroll") for (int _i = 0; _i < 2; ++_i) \
        __builtin_amdgcn_raw_ptr_buffer_load_lds(rs, (LAS unsigned*)(lds + (bufoff) + ldsw + _i * 8192), 16, (int)(voff)[_i], so_, 0, 0); } while (0)
#define PG8_STAGE(bufoff, gbase, voff) do { if constexpr (((bufoff) / HTB) < 4) PG8_STAGE_X(bufoff, rsA, g.A, gbase, voff); else PG8_STAGE_X(bufoff, rsB, g.Bt, gbase, voff); } while (0)
#define PG8_LD32(p) ({ const u32x4 lo_ = *(const LAS u32x4*)(p), hi_ = *(const LAS u32x4*)((p) + 1024); (i32x8){(int)lo_.x, (int)lo_.y, (int)lo_.z, (int)lo_.w, (int)hi_.x, (int)hi_.y, (int)hi_.z, (int)hi_.w}; })
#define PG8_LDA(dst, b, h) do { if constexpr (F8) { _Pragma("unroll") for (int m = 0; m < 4; ++m) dst##8[m] = PG8_LD32(lds + PG8_SA(b, h) + aoff + m * 2048); } \
        else { _Pragma("unroll") for (int m = 0; m < 4; ++m) _Pragma("unroll") for (int k = 0; k < 2; ++k) dst[m][k] = *(const LAS f16x8*)(lds + PG8_SA(b, h) + aoff + m * 2048 + k * 1024); } } while (0)
#define PG8_LDB(dst, b, h) do { if constexpr (F8) { _Pragma("unroll") for (int n = 0; n < 2; ++n) dst##8[n] = PG8_LD32(lds + PG8_SB(b, h) + boff + n * 2048); } \
        else { _Pragma("unroll") for (int n = 0; n < 2; ++n) _Pragma("unroll") for (int k = 0; k < 2; ++k) dst[n][k] = *(const LAS f16x8*)(lds + PG8_SB(b, h) + boff + n * 2048 + k * 1024); } } while (0)
#define PG8_MMA(ai, bj, At, Bt) do { __builtin_amdgcn_s_setprio(1); _Pragma("unroll") for (int m = 0; m < 4; ++m) _Pragma("unroll") for (int n = 0; n < 2; ++n) { \
        if constexpr (F8) asm volatile("v_mfma_scale_f32_16x16x128_f8f6f4 %0, %1, %2, %0, %3, %3 op_sel_hi:[0,0,0]" : "+v"(acc[ai][bj][m][n]) : "v"(Bt##8[n]), "v"(At##8[m]), "v"(one8)); \
        else { _Pragma("unroll") for (int k = 0; k < 2; ++k) acc[ai][bj][m][n] = __builtin_amdgcn_mfma_f32_16x16x32_f16(Bt[n][k], At[m][k], acc[ai][bj][m][n], 0, 0, 0); } } __builtin_amdgcn_s_setprio(0); } while (0)
#define PG8_WAIT_V(n) asm volatile("s_waitcnt vmcnt(" #n ")" ::: "memory")
#define PG8_WAIT_L(n) asm volatile("s_waitcnt lgkmcnt(" #n ")" ::: "memory")
#define PG8_BAR __builtin_amdgcn_s_barrier()
#define PG8_SCHED __builtin_amdgcn_sched_barrier(0)
    Unit cur, nxt; int ui = 0;
    if (!S.next(0, cur)) return;
    f32x4 acc[2][2][4][2];
#pragma unroll
    for (int a = 0; a < 2; ++a)
#pragma unroll
        for (int b = 0; b < 2; ++b)
#pragma unroll
            for (int m = 0; m < 4; ++m)
#pragma unroll
                for (int n = 0; n < 2; ++n) acc[a][b][m][n] = (f32x4){0.f, 0.f, 0.f, 0.f};
    f16x8 At[4][2], B0[2][2], B1[2][2];
    i32x8 At8[4], B08[2], B18[2];
    int one8 = 127; asm volatile("" : "+v"(one8));
    const char* cA = GA ? (const char*)g.A : (const char*)g.A + (size_t)cur.pm * tstepA; const char* cB = (const char*)g.Bt + (size_t)cur.pn * tstepB;
    if constexpr (GA) {
#pragma unroll
        for (int h = 0; h < 2; ++h)
#pragma unroll
            for (int i = 0; i < 2; ++i) offA[h][i] = (unsigned)S.arow(cur, h * HALF + RA[i]) * (unsigned)(g.lda * 2) + (unsigned)(CA[i] * 2);
    }
    PG8_STAGE(PG8_SB(0, 0), cB, voffB); PG8_STAGE(PG8_SB(0, 1), cB + hstepB, voffB); PG8_STAGE(PG8_SA(0, 0), cA, offA[0]); PG8_STAGE(PG8_SA(0, 1), cA, offA[1]);
    if (wr == 1) PG8_BAR;
    PG8_WAIT_V(2); PG8_BAR;
    PG8_STAGE(PG8_SB(1, 0), cB + kstepB, voffB); PG8_STAGE(PG8_SA(1, 0), cA + kstep, offA[0]); PG8_STAGE(PG8_SB(1, 1), cB + hstepB + kstepB, voffB);
    PG8_WAIT_V(6); PG8_BAR;
    for (;;) {
        const bool has_next = S.next(ui + 1, nxt);
        const char* nA = has_next ? (GA ? (const char*)g.A : (const char*)g.A + (size_t)nxt.pm * tstepA) : cA; const char* nB = has_next ? (const char*)g.Bt + (size_t)nxt.pn * tstepB : cB;
        if constexpr (GA) {
#pragma unroll
            for (int h = 0; h < 2; ++h)
#pragma unroll
                for (int i = 0; i < 2; ++i) offAn[h][i] = has_next ? (unsigned)S.arow(nxt, h * HALF + RA[i]) * (unsigned)(g.lda * 2) + (unsigned)(CA[i] * 2) : offA[h][i];
        }
#pragma unroll 1
        for (int t = 0; t < nt; t += 2) {
            const bool last = (t == nt - 2);
            const char* a1 = cA + (size_t)(t + 1) * kstep;
            const char* a2 = last ? nA : cA + (size_t)(t + 2) * kstep; const char* b2 = last ? nB : cB + (size_t)(t + 2) * kstepB;
            const char* a3 = a2 + kstep; const char* b3 = b2 + kstepB;
            unsigned o2[2][2];
#pragma unroll
            for (int h = 0; h < 2; ++h)
#pragma unroll
                for (int i = 0; i < 2; ++i) o2[h][i] = (GA && last) ? offAn[h][i] : offA[h][i];
            PG8_LDB(B0, 0, 0); PG8_LDB(B1, 0, 1); PG8_SCHED; PG8_LDA(At, 0, 0); PG8_STAGE(PG8_SA(1, 1), a1, offA[1]);
            PG8_WAIT_V(8); PG8_WAIT_L(0); PG8_BAR; PG8_MMA(0, 0, At, B0); PG8_MMA(0, 1, At, B1); PG8_BAR; PG8_SCHED;
            PG8_LDA(At, 0, 1); PG8_STAGE(PG8_SB(0, 0), b2, voffB); PG8_STAGE(PG8_SB(0, 1), b2 + hstepB, voffB); PG8_STAGE(PG8_SA(0, 0), a2, o2[0]);
            PG8_WAIT_V(8); PG8_WAIT_L(0); PG8_BAR; PG8_MMA(1, 0, At, B0); PG8_MMA(1, 1, At, B1); PG8_BAR; PG8_SCHED;
            PG8_LDB(B0, 1, 0); PG8_LDB(B1, 1, 1); PG8_SCHED; PG8_LDA(At, 1, 0); PG8_STAGE(PG8_SA(0, 1), a2, o2[1]);
            PG8_WAIT_V(8); PG8_WAIT_L(0); PG8_BAR; PG8_MMA(0, 0, At, B0); PG8_MMA(0, 1, At, B1); PG8_BAR; PG8_SCHED;
            PG8_LDA(At, 1, 1); PG8_STAGE(PG8_SB(1, 0), b3, voffB); PG8_STAGE(PG8_SB(1, 1), b3 + hstepB, voffB); PG8_STAGE(PG8_SA(1, 0), a3, o2[0]);
            PG8_WAIT_V(8); PG8_WAIT_L(0); PG8_BAR; PG8_MMA(1, 0, At, B0); PG8_MMA(1, 1, At, B1); PG8_BAR; PG8_SCHED;
        }
        if constexpr (ALIGN_EPI) { if (wr == 0) PG8_BAR; }
        if constexpr (F8) asm volatile("s_nop 15\n\ts_nop 15\n\ts_nop 7" ::: "memory");
        E(acc, cur, wr, wc, fr, fq);
        if (!has_next) break;
#pragma unroll
        for (int a = 0; a < 2; ++a)
#pragma unroll
            for (int b = 0; b < 2; ++b)
#pragma unroll
                for (int m = 0; m < 4; ++m)
#pragma unroll
                    for (int n = 0; n < 2; ++n) acc[a][b][m][n] = (f32x4){0.f, 0.f, 0.f, 0.f};
        cur = nxt; cA = nA; cB = nB; ++ui;
        if constexpr (GA) {
#pragma unroll
            for (int h = 0; h < 2; ++h)
#pragma unroll
                for (int i = 0; i < 2; ++i) offA[h][i] = offAn[h][i];
        }
        if constexpr (ALIGN_EPI) { if (wr == 1) PG8_BAR; }
    }
    PG8_WAIT_V(0);
    if constexpr (!ALIGN_EPI) { if (wr == 0) PG8_BAR; }
    PG8_BAR;
#undef PG8_SA
#undef PG8_SB
#undef PG8_STAGE
#undef PG8_STAGE_X
#undef PG8_LDA
#undef PG8_LDB
#undef PG8_MMA
#undef PG8_LD32
#undef PG8_WAIT_V
#undef PG8_WAIT_L
#undef PG8_BAR
#undef PG8_SCHED
}
}

struct EpiPlain {
    static constexpr bool PERM = true;
    f16* P;
    DEVINL void operator()(const f32x4 (&acc)[2][2][4][2], const g16::Unit& u, int wr, int wc, int fr, int fq) const {
#pragma unroll
        for (int bj = 0; bj < 2; ++bj)
#pragma unroll
            for (int ai = 0; ai < 2; ++ai)
#pragma unroll
                for (int m = 0; m < 4; ++m) {
                    const int row = u.pm * 256 + ai * 128 + wr * 64 + m * 16 + fr;
                    const f32x4 v0 = acc[ai][bj][m][0], v1 = acc[ai][bj][m][1];
                    u32x4 w; w.x = pk_f16(v0.x, v0.y); w.y = pk_f16(v0.z, v0.w); w.z = pk_f16(v1.x, v1.y); w.w = pk_f16(v1.z, v1.w);
                    *(u32x4*)(P + (size_t)row * NV + u.pn * 256 + bj * 128 + wc * 32 + 8 * fq) = w;
                }
    }
};
struct EpiInProj {
    static constexpr bool PERM = true;
    f16* P; const float* tab; float* ssq; float* sskv; const float* ikv;
    DEVINL void operator()(const f32x4 (&acc)[2][2][4][2], const g16::Unit& u, int wr, int wc, int fr, int fq) const {
        const bool ikwave = (u.pn == 19) && (wc == 0);
        if (ikwave) {
            const f32x4 g00 = *(const f32x4*)(ikv + 8 * fq), g01 = *(const f32x4*)(ikv + 8 * fq + 4), g10 = *(const f32x4*)(ikv + 32 + 8 * fq), g11 = *(const f32x4*)(ikv + 36 + 8 * fq);
            const f32x4 b00 = *(const f32x4*)(ikv + 64 + 8 * fq), b01 = *(const f32x4*)(ikv + 68 + 8 * fq), b10 = *(const f32x4*)(ikv + 96 + 8 * fq), b11 = *(const f32x4*)(ikv + 100 + 8 * fq);
#pragma unroll
            for (int ai = 0; ai < 2; ++ai)
#pragma unroll
                for (int m = 0; m < 4; ++m) {
                    const int row = u.pm * 256 + ai * 128 + wr * 64 + m * 16 + fr;
                    f32x4 a0 = acc[ai][0][m][0], a1 = acc[ai][0][m][1], c0 = acc[ai][1][m][0], c1 = acc[ai][1][m][1];
                    float sm = ((a0.x + a0.y) + (a0.z + a0.w)) + ((a1.x + a1.y) + (a1.z + a1.w)) + ((c0.x + c0.y) + (c0.z + c0.w)) + ((c1.x + c1.y) + (c1.z + c1.w));
                    sm += __shfl_xor(sm, 16); sm += __shfl_xor(sm, 32);
                    const float mean = sm * (1.f / 64.f);
                    a0 = a0 - mean; a1 = a1 - mean; c0 = c0 - mean; c1 = c1 - mean;
                    float sq = ((a0.x * a0.x + a0.y * a0.y) + (a0.z * a0.z + a0.w * a0.w)) + ((a1.x * a1.x + a1.y * a1.y) + (a1.z * a1.z + a1.w * a1.w))
                             + ((c0.x * c0.x + c0.y * c0.y) + (c0.z * c0.z + c0.w * c0.w)) + ((c1.x * c1.x + c1.y * c1.y) + (c1.z * c1.z + c1.w * c1.w));
                    sq += __shfl_xor(sq, 16); sq += __shfl_xor(sq, 32);
                    const float rstd = 1.f / sqrtf(sq * (1.f / 64.f) + EPS);
                    a0 = a0 * rstd * g00 + b00; a1 = a1 * rstd * g01 + b01; c0 = c0 * rstd * g10 + b10; c1 = c1 * rstd * g11 + b11;
                    const f32x4 cs = *(const f32x4*)(tab + (size_t)row * TABW + T_CI + 4 * (fq & 1)), sn = *(const f32x4*)(tab + (size_t)row * TABW + T_SI + 4 * (fq & 1));
                    const f32x4 r0 = a0 * cs - a1 * sn, r1 = a1 * cs + a0 * sn;
                    if (fq < 2) { a0 = r0; a1 = r1; }
                    u32x4 w; w.x = pk_f16(a0.x, a0.y); w.y = pk_f16(a0.z, a0.w); w.z = pk_f16(a1.x, a1.y); w.w = pk_f16(a1.z, a1.w);
                    *(u32x4*)(P + (size_t)row * NV + V_IK_LO + 8 * fq) = w;
                    w.x = pk_f16(c0.x, c0.y); w.y = pk_f16(c0.z, c0.w); w.z = pk_f16(c1.x, c1.y); w.w = pk_f16(c1.z, c1.w);
                    *(u32x4*)(P + (size_t)row * NV + V_IK_HI + 8 * fq) = w;
                }
            return;
        }
#pragma unroll
        for (int bj = 0; bj < 2; ++bj) {
            const int g32 = u.pn * 8 + bj * 4 + wc;
            int kind = 0, toc = 0, tos = 0, gi = 0;
            if (g32 < 64) { if ((g32 & 3) == 0) { kind = 1; toc = T_CA; tos = T_SA; } }
            else if (g32 < 96) { }
            else if (g32 < 128) { if ((g32 & 1) == 0) { kind = 2; toc = T_CI; tos = T_SI; } }
            else if (g32 < 144) { kind = 3; gi = g32 - 128; }
            else if (g32 < 152) { kind = 4; gi = g32 - 144; }
            else if (g32 == 154) { kind = 1; toc = T_CR; tos = T_SR; }
            else if (g32 == 155) { kind = 1; toc = T_CR + 16; tos = T_SR + 16; }
#pragma unroll
            for (int ai = 0; ai < 2; ++ai)
#pragma unroll
                for (int m = 0; m < 4; ++m) {
                    const int row = u.pm * 256 + ai * 128 + wr * 64 + m * 16 + fr;
                    f32x4 v0 = acc[ai][bj][m][0], v1 = acc[ai][bj][m][1];
                    if (kind == 1 || kind == 2) {
                        const int fqq = (kind == 2) ? (fq & 1) : fq;
                        const f32x4 c = *(const f32x4*)(tab + (size_t)row * TABW + toc + 4 * fqq), sn = *(const f32x4*)(tab + (size_t)row * TABW + tos + 4 * fqq);
                        const f32x4 r0 = v0 * c - v1 * sn, r1 = v1 * c + v0 * sn;
                        if (kind == 1 || fq < 2) { v0 = r0; v1 = r1; }
                    } else if (kind == 3 || kind == 4) {
                        float ss = (v0.x * v0.x + v0.y * v0.y) + (v0.z * v0.z + v0.w * v0.w) + (v1.x * v1.x + v1.y * v1.y) + (v1.z * v1.z + v1.w * v1.w);
                        ss += __shfl_xor(ss, 16); ss += __shfl_xor(ss, 32);
                        if (fq == 0) { if (kind == 3) ssq[(size_t)row * 16 + gi] = ss; else sskv[(size_t)row * 8 + gi] = ss; }
                    }
                    u32x4 w; w.x = pk_f16(v0.x, v0.y); w.y = pk_f16(v0.z, v0.w); w.z = pk_f16(v1.x, v1.y); w.w = pk_f16(v1.z, v1.w);
                    *(u32x4*)(P + (size_t)row * NV + u.pn * 256 + bj * 128 + wc * 32 + 8 * fq) = w;
                }
        }
    }
};


DEVINL void p_merge16(Frame& F) {
    const int gw = F.bid * NWAVES + F.wave, NGW = F.G * NWAVES;
    for (int m = gw; m < NT; m += NGW) {
#pragma unroll
        for (int half = 0; half < 2; ++half) {
            const f16* p = F.att16 + (size_t)m * D + half * 1024 + 4 * F.lane;
            f32x4 v[4]; float ss = 0.f;
#pragma unroll
            for (int j = 0; j < 4; ++j) { v[j] = ld4h(p + 256 * j); ss += (v[j].x * v[j].x + v[j].y * v[j].y) + (v[j].z * v[j].z + v[j].w * v[j].w); }
            const float r = 1.f / sqrtf(wave_sum(ss) * (1.f / 1024.f) + EPS);
#if OUTPROJ_F8
            unsigned* o = (unsigned*)((unsigned char*)F.mrgh + (size_t)m * D + half * 1024) + F.lane;
#pragma unroll
            for (int j = 0; j < 4; ++j) { const f32x4 y = v[j] * r; o[64 * j] = pk4_fp8(y.x, y.y, y.z, y.w); }
#else
            u32x2* o = (u32x2*)(F.mrgh + (size_t)m * D + half * 1024) + F.lane;
#pragma unroll
            for (int j = 0; j < 4; ++j) { const f32x4 y = v[j] * r; o[64 * j] = (u32x2){pk_f16(y.x, y.y), pk_f16(y.z, y.w)}; }
#endif
        }
    }
}
struct EpiPre16 {
    static constexpr bool PERM = true;
    f16* C; const float* x; const float* ada; float ascale;
    DEVINL void operator()(const f32x4 (&acc)[2][2][4][2], const g16::Unit& u, int wr, int wc, int fr, int fq) const {
        const int row0 = u.pm * 256 + wr * 64 + fr, col0 = u.pn * 256 + wc * 32 + 8 * fq;
        const float* g1 = ada + (size_t)((u.pm * 256) / S) * 6 * D + 2 * D;
        f32x4 gv[2][2];
#pragma unroll
        for (int bj = 0; bj < 2; ++bj)
#pragma unroll
            for (int n = 0; n < 2; ++n) gv[bj][n] = *(const f32x4*)(g1 + col0 + bj * 128 + n * 4) * ascale;
#pragma unroll
        for (int ai = 0; ai < 2; ++ai)
#pragma unroll
            for (int m = 0; m < 4; ++m) { const size_t ro = (size_t)(row0 + ai * 128 + m * 16) * D + col0;
#pragma unroll
                for (int bj = 0; bj < 2; ++bj) {
                    const f32x4 a = *(const f32x4*)(x + ro + bj * 128) * ALPHA + gv[bj][0] * acc[ai][bj][m][0], b = *(const f32x4*)(x + ro + bj * 128 + 4) * ALPHA + gv[bj][1] * acc[ai][bj][m][1];
                    u32x4 w; w.x = pk_f16(a.x, a.y); w.y = pk_f16(a.z, a.w); w.z = pk_f16(b.x, b.y); w.w = pk_f16(b.z, b.w);
                    *(u32x4*)(C + ro + bj * 128) = w; } }
    }
};
struct MoeLds { int cnt[NE], P[NE], cum[NE + 1], pbase[NE + 1]; };
DEVINL void moe_lds_build(Frame& F, LAS MoeLds* T) {
    __syncthreads();
    if (F.tid == 0) {
        int cu = 0;
        for (int e = 0; e < NE; ++e) { const int c = (int)__hip_atomic_load(F.ctl + CW_CNT + e, __ATOMIC_RELAXED, __HIP_MEMORY_SCOPE_AGENT); const int p = (c + 255) >> 8; T->cnt[e] = c; T->P[e] = p; T->cum[e] = cu; T->pbase[e] = cu; cu += p; }
        T->cum[NE] = cu; T->pbase[NE] = cu;
    }
    __syncthreads();
}
template <int CTX, bool GA_ = (CTX == 2)>
struct MoeOrder {
    static constexpr bool GATHER = GA_;
    const LAS MoeLds* T; const int* list; int x, j, nj;
    DEVINL bool next(int i, g16::Unit& u) const {
        const int li = j + i * nj;
        if (li >= CTX * T->cum[NE]) return false;
        int e = 0;
#pragma unroll 1
        while (e < NE - 1 && li >= CTX * T->cum[e + 1]) ++e;
        const int rem = li - CTX * T->cum[e], P = T->P[e], ctl = rem / P, p = rem - ctl * P, ct = x + 8 * ctl;
        u.pm = T->pbase[e] + p; u.pn = e * (8 * CTX) + ct; u.aux = e + 32 * p; return true;
    }
    DEVINL int arow(const g16::Unit& u, int r) const {
        const int e = u.aux & 31, p = u.aux >> 5, c = T->cnt[e]; int rr = p * 256 + r; rr = rr < c ? rr : c - 1;
        return list[(size_t)e * LISTCAP + rr] >> 2;
    }
};
struct EpiGU8 {
    static constexpr bool PERM = true;
    unsigned char* act; const float* bguP; int probe;
    DEVINL void operator()(const f32x4 (&acc)[2][2][4][2], const g16::Unit& u, int wr, int wc, int fr, int fq) const {
        if (probe) { asm volatile("" :: "v"(acc[0][0][0][0]), "v"(acc[1][1][3][1])); return; }
        const int e = u.aux & 31, ct = u.pn & 15;
        const float* bp = bguP + (size_t)e * 2 * DFF + ct * 256 + wc * 32 + 8 * fq;
        const f32x4 bg0 = *(const f32x4*)(bp), bg1 = *(const f32x4*)(bp + 4), bu0 = *(const f32x4*)(bp + 128), bu1 = *(const f32x4*)(bp + 132);
#pragma unroll
        for (int ai = 0; ai < 2; ++ai)
#pragma unroll
            for (int m = 0; m < 4; ++m) {
                const size_t row = (size_t)u.pm * 256 + ai * 128 + wr * 64 + m * 16 + fr;
                float o[8];
#pragma unroll
                for (int n = 0; n < 2; ++n) {
                    const f32x4 gq = acc[ai][0][m][n] * W8_INV + (n ? bg1 : bg0), uq = acc[ai][1][m][n] * W8_INV + (n ? bu1 : bu0);
#pragma unroll
                    for (int j = 0; j < 4; ++j) { const float g = fminf(gq[j], 7.0f), uu = fminf(fmaxf(uq[j], -7.0f), 7.0f); o[4 * n + j] = (uu + 1.f) * (g * __builtin_amdgcn_rcpf(1.f + __builtin_amdgcn_exp2f(-1.702f * 1.4426950408889634f * g))); }
                }
                const u32x2 w = {pk4_fp8(o[0], o[1], o[2], o[3]), pk4_fp8(o[4], o[5], o[6], o[7])};
                *(u32x2*)(act + row * DFF + ct * 128 + wc * 32 + 8 * fq) = w;
            }
    }
};
struct EpiGU16 {
    static constexpr bool PERM = true;
    f16* act; const float* bguP;
    DEVINL void operator()(const f32x4 (&acc)[2][2][4][2], const g16::Unit& u, int wr, int wc, int fr, int fq) const {
        const int e = u.aux & 31, ct = u.pn & 15;
        const float* bp = bguP + (size_t)e * 2 * DFF + ct * 256 + wc * 32 + 8 * fq;
        const f32x4 bg0 = *(const f32x4*)(bp), bg1 = *(const f32x4*)(bp + 4), bu0 = *(const f32x4*)(bp + 128), bu1 = *(const f32x4*)(bp + 132);
#pragma unroll
        for (int ai = 0; ai < 2; ++ai)
#pragma unroll
            for (int m = 0; m < 4; ++m) {
                const size_t row = (size_t)u.pm * 256 + ai * 128 + wr * 64 + m * 16 + fr;
                float o[8];
#pragma unroll
                for (int n = 0; n < 2; ++n) {
                    const f32x4 gq = acc[ai][0][m][n] + (n ? bg1 : bg0), uq = acc[ai][1][m][n] + (n ? bu1 : bu0);
#pragma unroll
                    for (int j = 0; j < 4; ++j) { const float g = fminf(gq[j], 7.0f), uu = fminf(fmaxf(uq[j], -7.0f), 7.0f); o[4 * n + j] = (uu + 1.f) * (g / (1.f + __expf(-1.702f * g))); }
                }
                u32x4 w; w.x = pk_f16(o[0], o[1]); w.y = pk_f16(o[2], o[3]); w.z = pk_f16(o[4], o[5]); w.w = pk_f16(o[6], o[7]);
                *(u32x4*)(act + row * DFF + ct * 128 + wc * 32 + 8 * fq) = w;
            }
    }
};
struct EpiDown16 {
    static constexpr bool PERM = true;
    f16* y; const float* b_dn; const int* list; const float* gate; const LAS MoeLds* T; float ascale;
    DEVINL void operator()(const f32x4 (&acc)[2][2][4][2], const g16::Unit& u, int wr, int wc, int fr, int fq) const {
        const int e = u.aux & 31, p = u.aux >> 5, ct = u.pn & 7, cnt = T->cnt[e];
        const float* bp = b_dn + (size_t)e * D + ct * 256 + wc * 32 + 8 * fq;
        f32x4 bv[2][2];
#pragma unroll
        for (int bj = 0; bj < 2; ++bj) { bv[bj][0] = *(const f32x4*)(bp + bj * 128); bv[bj][1] = *(const f32x4*)(bp + bj * 128 + 4); }
#pragma unroll
        for (int ai = 0; ai < 2; ++ai)
#pragma unroll
            for (int m = 0; m < 4; ++m) {
                const int rr = p * 256 + ai * 128 + wr * 64 + m * 16 + fr;
                if (rr < cnt) {
                    const int aid = list[(size_t)e * LISTCAP + rr]; const float gt = gate[aid];
#pragma unroll
                    for (int bj = 0; bj < 2; ++bj) {
                        const f32x4 a = (acc[ai][bj][m][0] * ascale + bv[bj][0]) * gt, b = (acc[ai][bj][m][1] * ascale + bv[bj][1]) * gt;
                        *(u32x2*)((unsigned char*)y + (size_t)aid * D + ct * 256 + bj * 128 + wc * 32 + 8 * fq) = (u32x2){pk4_fp8(a.x, a.y, a.z, a.w), pk4_fp8(b.x, b.y, b.z, b.w)};
                    }
                }
            }
    }
};
DEVINL f32x4 ld4q(const unsigned char* p) { const unsigned w = *(const unsigned*)p; const auto lo = __builtin_amdgcn_cvt_pk_f32_fp8(w, false), hi = __builtin_amdgcn_cvt_pk_f32_fp8(w, true); return (f32x4){lo[0], lo[1], hi[0], hi[1]}; }
DEVINL void p_final16(Frame& F) {
    const int gw = F.bid * NWAVES + F.wave, NGW = F.G * NWAVES, lane = F.lane;
    for (int m = gw; m < NT; m += NGW) {
        const int b = m / S;
        const f16* xr = (const f16*)F.x1 + (size_t)m * D + 4 * lane;
        const f32x4* g2 = (const f32x4*)(F.ada + (size_t)b * 6 * D + 5 * D) + lane;
        const unsigned char* y0 = (const unsigned char*)F.y16 + (size_t)m * 4 * D + 4 * lane;
        f32x4 v[8]; float s = 0.f;
#pragma unroll
        for (int j = 0; j < 8; ++j) {
            const f32x4 ys = ((ld4q(y0 + 256 * j) + ld4q(y0 + D + 256 * j)) + ld4q(y0 + 2 * D + 256 * j)) + ld4q(y0 + 3 * D + 256 * j);
            v[j] = ld4h(xr + 256 * j) * ALPHA + g2[64 * j] * ys; s += (v[j].x + v[j].y) + (v[j].z + v[j].w);
        }
        const float mean = wave_sum(s) * (1.f / D); float s2 = 0.f;
#pragma unroll
        for (int j = 0; j < 8; ++j) { v[j] = v[j] - mean; s2 += (v[j].x * v[j].x + v[j].y * v[j].y) + (v[j].z * v[j].z + v[j].w * v[j].w); }
        const float rstd = 1.f / sqrtf(wave_sum(s2) * (1.f / D) + EPS);
        const f32x4* g = (const f32x4*)F.lnfg + lane; const f32x4* bb = (const f32x4*)F.lnfb + lane;
        f32x4* o = (f32x4*)(F.out + (size_t)m * D) + lane;
#pragma unroll
        for (int j = 0; j < 8; ++j) o[64 * j] = v[j] * rstd * g[64 * j] + bb[64 * j];
    }
}

DEVINL float row_rstd(const float* ss, int n, float inv_n) { float a = 0.f; for (int i = 0; i < n; i += 4) { const f32x4 v = *(const f32x4*)(ss + i); a += (v.x + v.y) + (v.z + v.w); } return 1.f / sqrtf(a * inv_n + EPS); }
struct EpiQup {
    static constexpr bool PERM = true;
    f16* Q; const float* tab; const float* ssq;
    DEVINL void operator()(const f32x4 (&acc)[2][2][4][2], const g16::Unit& u, int wr, int wc, int fr, int fq) const {
#pragma unroll
        for (int ai = 0; ai < 2; ++ai)
#pragma unroll
            for (int m = 0; m < 4; ++m) {
                const int row = u.pm * 256 + ai * 128 + wr * 64 + m * 16 + fr;
                const float rs = row_rstd(ssq + (size_t)row * 16, 16, 1.f / 512.f);
#pragma unroll
                for (int bj = 0; bj < 2; ++bj) {
                    const int g32 = u.pn * 8 + bj * 4 + wc, hg = g32 % 6;
                    f32x4 v0 = acc[ai][bj][m][0] * rs, v1 = acc[ai][bj][m][1] * rs;
                    if (hg >= 4) {
                        const int to = (hg == 5) ? 16 : 0;
                        const f32x4 c = *(const f32x4*)(tab + (size_t)row * TABW + T_CR + to + 4 * fq), sn = *(const f32x4*)(tab + (size_t)row * TABW + T_SR + to + 4 * fq);
                        const f32x4 r0 = v0 * c - v1 * sn, r1 = v1 * c + v0 * sn; v0 = r0; v1 = r1;
                    }
                    u32x4 w; w.x = pk_f16(v0.x, v0.y); w.y = pk_f16(v0.z, v0.w); w.z = pk_f16(v1.x, v1.y); w.w = pk_f16(v1.z, v1.w);
                    *(u32x4*)(Q + (size_t)row * 1536 + u.pn * 256 + bj * 128 + wc * 32 + 8 * fq) = w;
                }
            }
    }
};
struct EpiKVup {
    static constexpr bool PERM = true;
    f16* KV; const float* sskv;
    DEVINL void operator()(const f32x4 (&acc)[2][2][4][2], const g16::Unit& u, int wr, int wc, int fr, int fq) const {
#pragma unroll
        for (int ai = 0; ai < 2; ++ai)
#pragma unroll
            for (int m = 0; m < 4; ++m) {
                const int row = u.pm * 256 + ai * 128 + wr * 64 + m * 16 + fr;
                const float rs = row_rstd(sskv + (size_t)row * 8, 8, 1.f / 256.f);
#pragma unroll
                for (int bj = 0; bj < 2; ++bj) {
                    const f32x4 v0 = acc[ai][bj][m][0] * rs, v1 = acc[ai][bj][m][1] * rs;
                    u32x4 w; w.x = pk_f16(v0.x, v0.y); w.y = pk_f16(v0.z, v0.w); w.z = pk_f16(v1.x, v1.y); w.w = pk_f16(v1.z, v1.w);
                    *(u32x4*)(KV + (size_t)row * D + u.pn * 256 + bj * 128 + wc * 32 + 8 * fq) = w;
                }
            }
    }
};

typedef short s16x4 __attribute__((ext_vector_type(4)));
DEVINL f16x4 tr_read(const LAS unsigned char* p) { return __builtin_bit_cast(f16x4, __builtin_amdgcn_ds_read_tr16_b64_v4i16((LAS s16x4*)p)); }
constexpr int AT_K1 = 0, AT_V = 16384, AT_K2 = 32768, AT_BUF = 40960;
template <bool MLA>
DEVINL void attn_unit16(LAS unsigned char* lds, const f16* Q1, const f16* Q2, int ldq, const f16* K1, int ldk1, const f16* K2, int ldk2, const f16* V, int ldv,
                        const u64* mask, f16* O, int ldo, int qb, float c2, int probe = 0) {
    constexpr int NS1 = 8, NS2 = MLA ? 4 : 0;
    int tid_ = threadIdx.x; asm volatile("" : "+v"(tid_));
    const int tid = tid_, lane = tid & 63, wid = __builtin_amdgcn_readfirstlane(tid >> 6), ql = lane & 31, hi = lane >> 5;
    const int qrow = wid * 32 + ql;
    const int mytiles = 4 * qb + (wid >> 1) + 1, nt = 4 * qb + 4;
    f16x8 qf[NS1 + NS2];
#pragma unroll
    for (int s2 = 0; s2 < NS1; ++s2) qf[s2] = *(const f16x8*)(Q1 + (size_t)qrow * ldq + 16 * s2 + 8 * hi);
    if constexpr (MLA) {
#pragma unroll
        for (int s2 = 0; s2 < NS2; ++s2) qf[NS1 + s2] = *(const f16x8*)(Q2 + (size_t)qrow * ldq + 16 * s2 + 8 * hi);
    }
    const int sr0 = tid >> 4, sc0 = tid & 15, sr2 = tid >> 3, sc2 = tid & 7;
    const unsigned gk1 = (unsigned)((sc0 ^ (sr0 & 15)) * 8), gv = (unsigned)((sc0 ^ (((sr0 & 3) << 2) | ((sr0 >> 2) & 3))) * 8), gk2 = (unsigned)((sc2 ^ (sr2 & 7)) * 8);
    const unsigned dsw = (unsigned)wid * 1024u;
    const unsigned ldsbase = (unsigned)(size_t)lds;
    const int mrow = (wid & 3) * 64 + lane;
#define AT_DMA(gp, off) do { unsigned keep_; const unsigned dst_ = (unsigned)__builtin_amdgcn_readfirstlane((int)(ldsbase + (unsigned)(off))); \
        asm volatile("s_mov_b32 %0, m0\n\ts_mov_b32 m0, %2\n\ts_nop 0\n\tglobal_load_lds_dwordx4 %1, off\n\ts_mov_b32 m0, %0" : "=&s"(keep_) : "v"((const void*)(gp)), "s"(dst_) : "memory"); } while (0)
#define AT_STAGE(t, b) do { const size_t kr = (size_t)(t) * 64 + sr0; LAS unsigned char* bp_ = lds + (b) * AT_BUF + dsw; \
        AT_DMA(K1 + kr * ldk1 + gk1, (b) * AT_BUF + AT_K1 + dsw); AT_DMA(K1 + (kr + 32) * ldk1 + gk1, (b) * AT_BUF + AT_K1 + 8192 + dsw); \
        AT_DMA(V + kr * ldv + gv, (b) * AT_BUF + AT_V + dsw); AT_DMA(V + (kr + 32) * ldv + gv, (b) * AT_BUF + AT_V + 8192 + dsw); \
        if constexpr (MLA) AT_DMA(K2 + ((size_t)(t) * 64 + sr2) * ldk2 + gk2, (b) * AT_BUF + AT_K2 + dsw); \
        else AT_DMA((const char*)mask + ((size_t)mrow * 64 + (size_t)(2 * ((t) >> 1))) * 8, (b) * AT_BUF + AT_K2 + dsw); (void)bp_; } while (0)
    const unsigned ka = (unsigned)(ql * 256) | (unsigned)((hi ^ (ql & 15)) << 4);
    const unsigned ka2 = (unsigned)(ql * 128) | (unsigned)((hi ^ (ql & 7)) << 4);
    const int tq = (lane & 15) >> 2, tp = lane & 3, gb = (lane >> 4) & 1;
    unsigned vb[2];
#pragma unroll
    for (int half = 0; half < 2; ++half) {
        const int row = 8 * half + 4 * hi + tq, low = (2 * gb + (tp >> 1)) ^ ((row >> 2) & 3);
        vb[half] = (unsigned)(row * 256 + (low << 4) + 8 * (tp & 1));
    }
    f32x16 o[4];
#pragma unroll
    for (int dt = 0; dt < 4; ++dt)
#pragma unroll
        for (int r = 0; r < 16; ++r) o[dt][r] = 0.f;
    float m_run = -1e30f, l_run = 0.f;
    __syncthreads();
    AT_STAGE(0, 0); AT_STAGE(1, 1);
#pragma unroll
    for (int s2 = 0; s2 < NS1 + NS2; ++s2) {
#pragma unroll
        for (int j = 0; j < 8; ++j) qf[s2][j] = (f16)((float)qf[s2][j] * c2);
        asm volatile("" : "+v"(qf[s2])); }
    asm volatile("s_waitcnt vmcnt(5)" ::: "memory");
    __builtin_amdgcn_s_barrier();
    int slot = 0;
    for (int t = 0; t < (probe == 8 ? 0 : nt); ++t) {
        { const int s2n = slot + 2 >= 3 ? slot - 1 : slot + 2; if (t + 2 < nt && probe != 5 && probe != 7) AT_STAGE(t + 2, s2n); }
        if (t < mytiles) {
            const LAS unsigned char* bp = lds + slot * AT_BUF;
            f32x16 st[2];
            __builtin_amdgcn_s_setprio(1);
#pragma unroll
            for (int kb = 0; kb < 2; ++kb)
#pragma unroll
                for (int r = 0; r < 16; ++r) st[kb][r] = 0.f;
            if (probe != 4 && probe < 6) {
                f16x8 kf[2][NS1];
#pragma unroll
                for (int s2 = 0; s2 < NS1; ++s2)
#pragma unroll
                    for (int kb = 0; kb < 2; ++kb) kf[kb][s2] = *(const LAS f16x8*)(bp + AT_K1 + kb * 8192 + (ka ^ (unsigned)(32 * s2)));
                __builtin_amdgcn_sched_barrier(0);
#pragma unroll
                for (int s2 = 0; s2 < NS1; ++s2)
#pragma unroll
                    for (int kb = 0; kb < 2; ++kb) st[kb] = __builtin_amdgcn_mfma_f32_32x32x16_f16(kf[kb][s2], qf[s2], st[kb], 0, 0, 0);
            }
            if (MLA && probe != 4 && probe < 6) {
                f16x8 kf2[2][NS2 > 0 ? NS2 : 1];
#pragma unroll
                for (int s2 = 0; s2 < NS2; ++s2)
#pragma unroll
                    for (int kb = 0; kb < 2; ++kb) kf2[kb][s2] = *(const LAS f16x8*)(bp + AT_K2 + kb * 4096 + (ka2 ^ (unsigned)(32 * s2)));
                __builtin_amdgcn_sched_barrier(0);
#pragma unroll
                for (int s2 = 0; s2 < NS2; ++s2)
#pragma unroll
                    for (int kb = 0; kb < 2; ++kb) st[kb] = __builtin_amdgcn_mfma_f32_32x32x16_f16(kf2[kb][s2], qf[NS1 + s2], st[kb], 0, 0, 0);
            }
            __builtin_amdgcn_s_setprio(0);
            if (probe != 2 && probe < 6) {
            u64 mw = ~0ull;
            if constexpr (!MLA) mw = *(const LAS u64*)(bp + AT_K2 + qrow * 16 + (t & 1) * 8) >> (4 * hi);
            float mx = -INFINITY;
#pragma unroll
            for (int kb = 0; kb < 2; ++kb)
#pragma unroll
                for (int r = 0; r < 16; ++r) { const int bit = 32 * kb + (r & 3) + 8 * (r >> 2); const float x = ((mw >> bit) & 1ull) ? st[kb][r] : -INFINITY; st[kb][r] = x; mx = fmaxf(mx, x); }
            mx = fmaxf(mx, __shfl_xor(mx, 32));
            const float mn = fmaxf(m_run, mx), alpha = __builtin_amdgcn_exp2f(m_run - mn);
            float ps = 0.f;
#pragma unroll
            for (int kb = 0; kb < 2; ++kb)
#pragma unroll
                for (int r = 0; r < 16; ++r) { const float p = __builtin_amdgcn_exp2f(st[kb][r] - mn); st[kb][r] = p; ps += p; }
            ps += __shfl_xor(ps, 32);
            const float m_old = m_run;
            l_run = l_run * alpha + ps; m_run = mn;
            if (!__all(mn == m_old)) {
#pragma unroll
                for (int dt = 0; dt < 4; ++dt)
#pragma unroll
                    for (int r = 0; r < 16; ++r) o[dt][r] *= alpha;
            }
            }
            __builtin_amdgcn_s_setprio(1);
            if (probe != 3 && probe < 6)
#pragma unroll
            for (int kb = 0; kb < 2; ++kb)
#pragma unroll
                for (int s2 = 0; s2 < 2; ++s2) {
                    f16x8 pf;
#pragma unroll
                    for (int j = 0; j < 8; ++j) pf[j] = (f16)st[kb][8 * s2 + j];
#pragma unroll
                    for (int dt = 0; dt < 4; ++dt) {
                        const unsigned dsw = (unsigned)((dt ^ tq) << 6);
                        const f16x4 x0 = tr_read(bp + AT_V + (32 * kb + 16 * s2) * 256 + (vb[0] + dsw)), x1 = tr_read(bp + AT_V + (32 * kb + 16 * s2) * 256 + (vb[1] + dsw));
                        const f16x8 a = {x0[0], x0[1], x0[2], x0[3], x1[0], x1[1], x1[2], x1[3]};
                        o[dt] = __builtin_amdgcn_mfma_f32_32x32x16_f16(a, pf, o[dt], 0, 0, 0);
                    }
                }
        }
        __builtin_amdgcn_s_setprio(0);
        if (t + 2 < nt) asm volatile("s_waitcnt vmcnt(5)" ::: "memory");
        else asm volatile("s_waitcnt vmcnt(0)" ::: "memory");
        asm volatile("s_waitcnt lgkmcnt(0)" ::: "memory");
        __builtin_amdgcn_s_barrier();
        slot = slot + 1 >= 3 ? 0 : slot + 1;
    }
    if (probe) { asm volatile("" :: "v"(o[0]), "v"(o[1]), "v"(o[2]), "v"(o[3]), "v"(l_run)); return; }
    const float inv = 1.f / l_run;
#pragma unroll
    for (int dt = 0; dt < 4; ++dt)
#pragma unroll
        for (int g = 0; g < 4; ++g) {
            const u32x2 w = {pk_f16(o[dt][4 * g] * inv, o[dt][4 * g + 1] * inv), pk_f16(o[dt][4 * g + 2] * inv, o[dt][4 * g + 3] * inv)};
            *(u32x2*)(O + (size_t)qrow * ldo + 32 * dt + 8 * g + 4 * hi) = w;
        }
#undef AT_DMA
#undef AT_STAGE
}
DEVINL void p_attn16(Frame& F, LAS unsigned char* lds, int probe = 0) {
    for (int p = F.bid; p < 512; p += F.G) {
        const int kind = p >> 8, bh = (p & 7) * 4 + ((p >> 6) & 3), b = bh >> 3, hd = bh & 7, x = (p >> 3) & 7;
#pragma unroll 1
        for (int half = 0; half < 2; ++half) {
            const int qb = half ? x : 15 - x;
            const size_t t0 = (size_t)b * S + (size_t)qb * 256, tb = (size_t)b * S;
            if (kind == 0)
                attn_unit16<false>(lds, F.projh + t0 * NV + V_AQ + hd * 128, nullptr, NV, F.projh + tb * NV + V_AK + hd * 128, NV, nullptr, 0, F.projh + tb * NV + V_AV + hd * 128, NV,
                                   F.mask + t0 * 64, F.att16 + t0 * D + hd * 128, D, qb, 0.08838834764831845f * 1.4426950408889634f, probe);
            else
                attn_unit16<true>(lds, F.qb16 + t0 * 1536 + hd * 192, F.qb16 + t0 * 1536 + hd * 192 + 128, 1536, F.kv16 + tb * D + hd * 256, D, F.projh + tb * NV + V_KR, NV, F.kv16 + tb * D + hd * 256 + 128, D,
                                  nullptr, F.att16 + t0 * D + 1024 + hd * 128, D, qb, 0.07216878364870322f * 1.4426950408889634f, probe);
        }
    }
}

DEVINL void p_tokpost(Frame& F) {
    const int gw = F.bid * NWAVES + F.wave, NGW = F.G * NWAVES, lane = F.lane;
    for (int m = gw; m < NT; m += NGW) {
        float sq = 0.f, skv = 0.f;
        if (lane < 16) sq = F.ssq[(size_t)m * 16 + lane];
        if (lane < 8) skv = F.sskv[(size_t)m * 8 + lane];
        const float rq = 1.f / sqrtf(wave_sum(sq) * (1.f / 512.f) + EPS), rkv = 1.f / sqrtf(wave_sum(skv) * (1.f / 256.f) + EPS);
        if (lane == 0) { F.rq[m] = rq; F.rkv[m] = rkv; }
        f16* pk = F.projh + (size_t)m * NV + (lane < 32 ? V_IK_LO + permI(lane) : V_IK_HI + (lane - 32));
        const float v = (float)*pk;
        const float mean = wave_sum(v) * (1.f / 64.f);
        const float d = v - mean;
        const float var = wave_sum(d * d) * (1.f / 64.f);
        float y = d * (1.f / sqrtf(var + EPS)) * F.ikg[lane] + F.ikb[lane];
        const float other = __shfl_xor(y, 8);
        const float c = F.tab[(size_t)m * TABW + T_CI + (lane & 7)], sn = F.tab[(size_t)m * TABW + T_SI + (lane & 7)];
        if (lane < 8) y = y * c - other * sn; else if (lane < 16) y = y * c + other * sn;
        *pk = (f16)y;
    }
}
DEVINL float relu_i(float x) { const int i = __builtin_bit_cast(int, x); return __builtin_bit_cast(float, i > 0 ? i : 0); }
DEVINL void p_index16(Frame& F, LAS unsigned char* lds, int probe = 0) {
    int tid_ = threadIdx.x; asm volatile("" : "+v"(tid_));
    const int tid = tid_, lane = tid & 63, wid = __builtin_amdgcn_readfirstlane(tid >> 6), ql = lane & 31, hi = lane >> 5;
    for (int u = F.bid; u < NT / 32; u += F.G) {
        const int rnd = u / F.G, c0 = u - rnd * F.G, j = (rnd & 1) ? (NT / 32 - 1 - c0 - (rnd >> 1) * F.G) : (c0 + (rnd >> 1) * F.G);
        const int ci = 63 - (j >> 3), b = (j >> 1) & 3, t0 = b * S + ci * 64 + (j & 1) * 32;
        __syncthreads();
#pragma unroll
        for (int it = 0; it < 8; ++it) {
            const int p = it * 8192 + tid * 16, q = p >> 11, pc = (p & 2047) >> 4, sc = pc ^ (q & 15);
            __builtin_amdgcn_global_load_lds((const unsigned*)(F.projh + (size_t)(t0 + q) * NV + V_IQ + sc * 8), (LAS unsigned*)(lds + it * 8192 + wid * 1024), 16, 0, 0);
        }
        LAS float* wl = (LAS float*)(lds + 65536);
        if (tid < 512) { const int q = tid >> 4, h = tid & 15; wl[q * 17 + h] = (float)F.projh[(size_t)(t0 + q) * NV + V_IW + h] * INDEX_SCALE; }
        __syncthreads();
        const unsigned qbase = (unsigned)(ql * 2048);
        f16x8 kn[2][4];
        {   const int kt0 = wid <= ci ? wid : ci;
#pragma unroll
            for (int kb = 0; kb < 2; ++kb)
#pragma unroll
                for (int s2 = 0; s2 < 4; ++s2) kn[kb][s2] = *(const f16x8*)(F.projh + ((size_t)b * S + kt0 * 64 + kb * 32 + ql) * NV + (s2 < 2 ? V_IK_LO + 16 * s2 : V_IK_HI + 16 * (s2 - 2)) + 8 * hi); }
        for (int kt = wid; kt <= ci; kt += NWAVES) {
            f16x8 ka[2][4];
#pragma unroll
            for (int kb = 0; kb < 2; ++kb)
#pragma unroll
                for (int s2 = 0; s2 < 4; ++s2) ka[kb][s2] = kn[kb][s2];
            {   const int ktn = kt + NWAVES <= ci ? kt + NWAVES : kt;
#pragma unroll
                for (int kb = 0; kb < 2; ++kb)
#pragma unroll
                    for (int s2 = 0; s2 < 4; ++s2) kn[kb][s2] = *(const f16x8*)(F.projh + ((size_t)b * S + ktn * 64 + kb * 32 + ql) * NV + (s2 < 2 ? V_IK_LO + 16 * s2 : V_IK_HI + 16 * (s2 - 2)) + 8 * hi); }
            f32x16 sc[2];
#pragma unroll
            for (int kb = 0; kb < 2; ++kb)
#pragma unroll
                for (int r = 0; r < 16; ++r) sc[kb][r] = 0.f;
#pragma unroll 2
            for (int h = 0; h < 16; ++h) {
                const float wh = wl[ql * 17 + h];
                f32x16 d0, d1;
#pragma unroll
                for (int r = 0; r < 16; ++r) { d0[r] = 0.f; d1[r] = 0.f; }
#pragma unroll
                for (int s2 = 0; s2 < 4; ++s2) {
                    const f16x8 qfrag = *(const LAS f16x8*)(lds + qbase + (((unsigned)(8 * h + 2 * s2 + hi) ^ (unsigned)(ql & 15)) << 4));
                    d0 = __builtin_amdgcn_mfma_f32_32x32x16_f16(ka[0][s2], qfrag, d0, 0, 0, 0);
                    d1 = __builtin_amdgcn_mfma_f32_32x32x16_f16(ka[1][s2], qfrag, d1, 0, 0, 0);
                }
#pragma unroll
                for (int r = 0; r < 16; ++r) { sc[0][r] += wh * relu_i(d0[r]); sc[1][r] += wh * relu_i(d1[r]); }
            }
            float* srow = F.score + (size_t)(t0 + ql) * S + kt * 64 + 4 * hi;
            if (probe == 1) { asm volatile("" :: "v"(sc[0]), "v"(sc[1])); continue; }
#pragma unroll
            for (int kb = 0; kb < 2; ++kb)
#pragma unroll
                for (int g4 = 0; g4 < 4; ++g4) *(f32x4*)(srow + kb * 32 + 8 * g4) = (f32x4){sc[kb][4 * g4], sc[kb][4 * g4 + 1], sc[kb][4 * g4 + 2], sc[kb][4 * g4 + 3]};
        }
    }
}
DEVINL int wave_prefix_incl(int x) {
    x += __builtin_amdgcn_update_dpp(0, x, 0x111, 0xf, 0xf, false);
    x += __builtin_amdgcn_update_dpp(0, x, 0x112, 0xf, 0xf, false);
    x += __builtin_amdgcn_update_dpp(0, x, 0x114, 0xf, 0xf, false);
    x += __builtin_amdgcn_update_dpp(0, x, 0x118, 0xf, 0xf, false);
    x += __builtin_amdgcn_update_dpp(0, x, 0x142, 0xa, 0xf, false);
    x += __builtin_amdgcn_update_dpp(0, x, 0x143, 0xc, 0xf, false);
    return x;
}
DEVINL int wave_total(int x) {
    x += __builtin_amdgcn_update_dpp(0, x, 0x111, 0xf, 0xf, false);
    x += __builtin_amdgcn_update_dpp(0, x, 0x112, 0xf, 0xf, false);
    x += __builtin_amdgcn_update_dpp(0, x, 0x114, 0xf, 0xf, false);
    x += __builtin_amdgcn_update_dpp(0, x, 0x118, 0xf, 0xf, false);
    x += __builtin_amdgcn_update_dpp(0, x, 0x142, 0xa, 0xf, false);
    x += __builtin_amdgcn_update_dpp(0, x, 0x143, 0xc, 0xf, false);
    return __builtin_amdgcn_readlane(x, 63);
}
template <int SHIFT, int NBITS>
DEVINL unsigned radix_pass(LAS unsigned* hist, const unsigned (&key)[64], int ci, unsigned hiprefix, int& K, int& cnt, int lane) {
    constexpr int NB = 1 << NBITS, PER = NB / 64;
#pragma unroll
    for (int j = 0; j < PER / 4; ++j) *(LAS u32x4*)(hist + PER * lane + 4 * j) = (u32x4){0u, 0u, 0u, 0u};
    asm volatile("s_waitcnt lgkmcnt(0)" ::: "memory");
#pragma unroll
    for (int g = 0; g < 4; ++g) if (16 * g <= ci) {
#pragma unroll
        for (int i = 16 * g; i < 16 * g + 16; ++i) {
            const unsigned kx = key[i];
            const bool in = (SHIFT + NBITS >= 32) ? (kx != 0u) : ((kx >> ((SHIFT + NBITS) & 31)) == hiprefix);
            if (in) __hip_atomic_fetch_add(hist + ((kx >> SHIFT) & (NB - 1)), 1u, __ATOMIC_RELAXED, __HIP_MEMORY_SCOPE_WORKGROUP);
        }
    }
    asm volatile("s_waitcnt lgkmcnt(0)" ::: "memory");
    unsigned c[PER]; int t = 0;
#pragma unroll
    for (int j = 0; j < PER / 4; ++j) { const u32x4 v = *(const LAS u32x4*)(hist + PER * (63 - lane) + 4 * j); c[4 * j] = v.x; c[4 * j + 1] = v.y; c[4 * j + 2] = v.z; c[4 * j + 3] = v.w; t += (int)(v.x + v.y + v.z + v.w); }
    const int incl = wave_prefix_incl(t);
    const int excl = incl - t;
    const u64 hit = __ballot(excl < K && K <= incl);
    const int ls = __builtin_amdgcn_readfirstlane(__builtin_ctzll(hit));
    const int kp = K - __builtin_amdgcn_readlane(excl, ls);
    int acc = 0, found = -1, above = 0, cf = 0;
#pragma unroll
    for (int j = PER - 1; j >= 0; --j) {
        const int cj = (int)__builtin_amdgcn_readlane(c[j], ls);
        const bool take = (found < 0) && (acc + cj >= kp);
        above = take ? acc : above; cf = take ? cj : cf; found = take ? j : found; acc += cj;
    }
    K = kp - above; cnt = cf;
    return (unsigned)(PER * (63 - ls) + found);
}
DEVINL void p_topk16(Frame& F, LAS unsigned char* lds) {
    const int gw = F.bid * NWAVES + F.wave, NGW = F.G * NWAVES, lane = F.lane;
    LAS unsigned* hist = (LAS unsigned*)(lds + F.wave * 8192);
#define TK_QUERY(qi_, q_, ci_) const int j_##q_ = (qi_) / NGW, base_##q_ = (qi_) % NGW, r_##q_ = (j_##q_ & 1) ? (NT - 1 - (base_##q_ + (j_##q_ >> 1) * NGW)) : (base_##q_ + (j_##q_ >> 1) * NGW); \
        const int q_ = (r_##q_ % 4) * S + (r_##q_ / 4); const int ci_ = __builtin_amdgcn_readfirstlane((q_ % S) >> 6);
#define TK_LOAD(dst_, q_, ci_) do { const float* srow_ = F.score + (size_t)(q_) * S + lane; _Pragma("unroll") for (int g = 0; g < 4; ++g) { if (16 * g <= (ci_) && (ci_) >= 4) { \
        _Pragma("unroll") for (int i = 16 * g; i < 16 * g + 16; ++i) dst_[i] = srow_[64 * i]; } } } while (0)
    float raw[64];
#pragma unroll
    for (int i = 0; i < 64; ++i) raw[i] = 0.f;
    if (gw < NT) { TK_QUERY(gw, q0, c0); TK_LOAD(raw, q0, c0); }
    for (int qi = gw; qi < NT; qi += NGW) {
        TK_QUERY(qi, q, ci);
        u64 myword = ~0ull;
        unsigned key[64];
#pragma unroll
        for (int i = 0; i < 64; ++i) { const unsigned m = ~(unsigned)((ci - i) >> 31); key[i] = f2key(raw[i]) & m; }
        if (qi + NGW < NT) { TK_QUERY(qi + NGW, qn, cn); TK_LOAD(raw, qn, cn); }
        if (ci >= 4) {
            int K = 256, cnt = 0;
            const unsigned bA = radix_pass<21, 11>(hist, key, ci, 0u, K, cnt, lane);
            const unsigned bB = radix_pass<10, 11>(hist, key, ci, bA, K, cnt, lane);
            const unsigned bC = radix_pass<0, 10>(hist, key, ci, (bA << 11) | bB, K, cnt, lane);
            const unsigned T = (bA << 21) | (bB << 10) | bC;
            unsigned wlo = 0u, whi = 0u;
            if (cnt == K) {
#pragma unroll
                for (int i = 0; i < 64; ++i) { const u64 sel = __ballot(key[i] >= T); const bool me = (lane == i); wlo = me ? (unsigned)sel : wlo; whi = me ? (unsigned)(sel >> 32) : whi; }
            } else {
                int need = K;
#pragma unroll 1
                for (int i = 0; i <= ci; ++i) {
                    unsigned kv = 0u;
#pragma unroll
                    for (int jj = 0; jj < 64; ++jj) kv = (i == jj) ? key[jj] : kv;
                    u64 sel = __ballot(kv > T); u64 t2 = __ballot(kv == T);
                    while (t2 && need > 0) { const u64 low = t2 & (0ull - t2); sel |= low; t2 ^= low; --need; }
                    if (lane == i) { wlo = (unsigned)sel; whi = (unsigned)(sel >> 32); }
                }
            }
            myword = ((u64)whi << 32) | wlo;
        }
        if (lane <= ci) F.mask[(size_t)q * 64 + lane] = myword;
    }
#undef TK_QUERY
#undef TK_LOAD
}
typedef float f32x4_t __attribute__((ext_vector_type(4)));
DEVINL void p_router16(Frame& F, LAS unsigned char* lds) {
    int tid_ = threadIdx.x; asm volatile("" : "+v"(tid_));
    const int tid = tid_, lane = tid & 63, wid = __builtin_amdgcn_readfirstlane(tid >> 6);
    LAS float* part = (LAS float*)(lds + 65536);
    for (int tile = F.bid; tile < NT / 16; tile += F.G) {
        __syncthreads();
        {
            f32x4 v[2][8]; float s[2], mean[2], s2[2], rstd[2];
            f16* xr[2];
#pragma unroll
            for (int rr = 0; rr < 2; ++rr) { xr[rr] = (f16*)F.x1 + (size_t)(tile * 16 + wid * 2 + rr) * D + 4 * lane; s[rr] = 0.f;
#pragma unroll
                for (int j = 0; j < 8; ++j) { v[rr][j] = ld4h(xr[rr] + 256 * j); s[rr] += (v[rr][j].x + v[rr][j].y) + (v[rr][j].z + v[rr][j].w); } }
#pragma unroll
            for (int rr = 0; rr < 2; ++rr) { mean[rr] = wave_sum(s[rr]) * (1.f / D); s2[rr] = 0.f;
#pragma unroll
                for (int j = 0; j < 8; ++j) { v[rr][j] = v[rr][j] - mean[rr]; s2[rr] += (v[rr][j].x * v[rr][j].x + v[rr][j].y * v[rr][j].y) + (v[rr][j].z * v[rr][j].z + v[rr][j].w * v[rr][j].w); } }
            const f32x4* g = (const f32x4*)F.lnmg + lane; const f32x4* bb = (const f32x4*)F.lnmb + lane;
#pragma unroll
            for (int rr = 0; rr < 2; ++rr) { rstd[rr] = 1.f / sqrtf(wave_sum(s2[rr]) * (1.f / D) + EPS); s[rr] = 0.f; }
#pragma unroll
            for (int j = 0; j < 8; ++j) { const f32x4 gj = g[64 * j], bj = bb[64 * j];
#pragma unroll
                for (int rr = 0; rr < 2; ++rr) { v[rr][j] = v[rr][j] * rstd[rr] * gj + bj; *(u32x2*)(xr[rr] + 256 * j) = (u32x2){pk_f16(v[rr][j].x, v[rr][j].y), pk_f16(v[rr][j].z, v[rr][j].w)}; s[rr] += (v[rr][j].x + v[rr][j].y) + (v[rr][j].z + v[rr][j].w); } }
#pragma unroll
            for (int rr = 0; rr < 2; ++rr) { mean[rr] = wave_sum(s[rr]) * (1.f / D); s2[rr] = 0.f;
#pragma unroll
                for (int j = 0; j < 8; ++j) { v[rr][j] = v[rr][j] - mean[rr]; s2[rr] += (v[rr][j].x * v[rr][j].x + v[rr][j].y * v[rr][j].y) + (v[rr][j].z * v[rr][j].z + v[rr][j].w * v[rr][j].w); } }
#pragma unroll
            for (int rr = 0; rr < 2; ++rr) rstd[rr] = 1.f / sqrtf(wave_sum(s2[rr]) * (1.f / D) + EPS);
            const int b = (tile * 16) / S;
            const f32x4* sh = (const f32x4*)(F.ada + (size_t)b * 6 * D + 3 * D) + lane;
            const f32x4* scp = (const f32x4*)(F.ada + (size_t)b * 6 * D + 4 * D) + lane;
#pragma unroll
            for (int j = 0; j < 8; ++j) { const f32x4 sc1 = scp[64 * j] + 1.f, shj = sh[64 * j];
#pragma unroll
                for (int rr = 0; rr < 2; ++rr) {
                    const int row = wid * 2 + rr;
                    const f32x4 y = v[rr][j] * rstd[rr] * sc1 + shj;
                    const u32x2 w = {pk_f16(y.x, y.y), pk_f16(y.z, y.w)};
                    ((unsigned*)((unsigned char*)F.hA + (size_t)(tile * 16 + row) * D) + lane)[64 * j] = pk4_fp8(y.x, y.y, y.z, y.w);
                    const int chunk = (lane >> 1) + 32 * j;
                    *(LAS u32x2*)(lds + row * 4096 + ((chunk ^ row) << 4) + 8 * (lane & 1)) = w;
                } }
        }
        __syncthreads();
        {
            f32x4 d0 = {0.f, 0.f, 0.f, 0.f}, d1 = d0;
            const int ar = lane & 15, aq = lane >> 4;
#pragma unroll
            for (int s2 = 0; s2 < 8; ++s2) {
                const int kk = 256 * wid + 32 * s2 + 8 * aq;
                const f16x8 a = *(const LAS f16x8*)(lds + ar * 4096 + ((((kk >> 3)) ^ ar) << 4));
                const f16x8 b0 = *(const f16x8*)(F.WrT + (size_t)ar * D + kk), b1 = *(const f16x8*)(F.WrT + (size_t)(16 + ar) * D + kk);
                d0 = __builtin_amdgcn_mfma_f32_16x16x32_f16(a, b0, d0, 0, 0, 0);
                d1 = __builtin_amdgcn_mfma_f32_16x16x32_f16(a, b1, d1, 0, 0, 0);
            }
#pragma unroll
            for (int r = 0; r < 4; ++r) { part[(wid * 16 + 4 * aq + r) * 32 + ar] = d0[r]; part[(wid * 16 + 4 * aq + r) * 32 + 16 + ar] = d1[r]; }
        }
        __syncthreads();
#pragma unroll 1
        for (int rr = 0; rr < 2; ++rr) {
            const int row = wid * 2 + rr, m = tile * 16 + row;
            float myv = -INFINITY;
            if (lane < 32) { float a = F.b_router[lane];
#pragma unroll
                for (int w = 0; w < 8; ++w) a += part[(w * 16 + row) * 32 + lane];
                myv = a; }
            int se[4]; float sv[4];
#pragma unroll
            for (int k = 0; k < 4; ++k) {
                float bv = myv; int bi = lane;
#pragma unroll
                for (int o = 1; o < 64; o <<= 1) { const float ov = __shfl_xor(bv, o); const int oi = __shfl_xor(bi, o); if (ov > bv || (ov == bv && oi < bi)) { bv = ov; bi = oi; } }
                se[k] = bi; sv[k] = bv; if (lane == bi) myv = -INFINITY;
            }
            const float e0 = 1.f, e1 = expf(sv[1] - sv[0]), e2 = expf(sv[2] - sv[0]), e3 = expf(sv[3] - sv[0]);
            const float inv = 1.f / (e0 + e1 + e2 + e3);
            if (lane < 4) {
                const int e = lane == 0 ? se[0] : lane == 1 ? se[1] : lane == 2 ? se[2] : se[3];
                const float gv = (lane == 0 ? e0 : lane == 1 ? e1 : lane == 2 ? e2 : e3) * inv;
                const unsigned p = atomicAdd(F.ctl + CW_CNT + e, 1u);
                F.list[(size_t)e * LISTCAP + p] = m * 4 + lane;
                F.tope[m * 4 + lane] = e; F.gate[m * 4 + lane] = gv;
            }
        }
    }
}
DEVINL void p_bridge_proj(Frame& F) {
    const int gw = F.bid * NWAVES + F.wave, NGW = F.G * NWAVES, lane = F.lane;
    for (int m = gw; m < NT; m += NGW) {
        const f16* ph = F.projh + (size_t)m * NV; float* p = F.proj + (size_t)m * INW;
        const float pos = (float)F.pos[m];
        float sq = 0.f, skv = 0.f;
        if (lane < 16) sq = F.ssq[(size_t)m * 16 + lane];
        if (lane < 8) skv = F.sskv[(size_t)m * 8 + lane];
        const float rq = 1.f / sqrtf(wave_sum(sq) * (1.f / 512.f) + EPS), rkv = 1.f / sqrtf(wave_sum(skv) * (1.f / 256.f) + EPS);
        if (lane == 0) { F.rq[m] = rq; F.rkv[m] = rkv; }
        for (int pc = lane; pc < INW; pc += 64) {
            if (pc >= O_IK && pc < O_IW) continue;
            float v = (float)ph[vcol_in(pc)];
            if (pc >= O_QD && pc < O_KVD) v = v * rq * F.qng[pc - O_QD];
            else if (pc >= O_KVD && pc < O_KR) v = v * rkv * F.kvng[pc - O_KVD];
            p[pc] = v;
        }
        {
            const float v = (float)ph[lane < 32 ? V_IK_LO + permI(lane) : V_IK_HI + (lane - 32)];
            const float mean = wave_sum(v) * (1.f / 64.f);
            const float d = v - mean;
            const float var = wave_sum(d * d) * (1.f / 64.f);
            float y = d * (1.f / sqrtf(var + EPS)) * F.ikg[lane] + F.ikb[lane];
            const float other = __shfl_xor(y, 8);
            float c, s; rope_cs(pos, lane & 7, 8, c, s);
            if (lane < 8) y = y * c - other * s; else if (lane < 16) y = y * c + other * s;
            p[O_IK + lane] = y;
        }
    }
}

#define XB_TMO      128
#define XB_XCNT(j)  (256  + 64 * (j))
#define XB_XSUB(j)  (1280 + 64 * (j))
#define XB_XGEN(j)  (2304 + 64 * (j))
#define XB_TOP      3328
#define XB_TOPGEN   3392
#define XCD_BAR_WORDS 3456
#define XB_SPIN_CAP (1u << 22)
__device__ __forceinline__ unsigned xb_ld(unsigned* p)              { return __hip_atomic_load(p, __ATOMIC_RELAXED, __HIP_MEMORY_SCOPE_AGENT); }
__device__ __forceinline__ unsigned xb_add(unsigned* p, unsigned v) { return __hip_atomic_fetch_add(p, v, __ATOMIC_RELAXED, __HIP_MEMORY_SCOPE_AGENT); }
__device__ __forceinline__ unsigned xb_xcc_id() { return (unsigned)__builtin_amdgcn_s_getreg((3 << 11) | 20) & 0xFu; }
#define XB_SPIN(cond, bar) do { unsigned _sp = 0; while (cond) { __builtin_amdgcn_s_sleep(1); \
    if ((++_sp & 255u) == 0u) { if (xb_ld(&(bar)[XB_TMO])) break; if (_sp > XB_SPIN_CAP) { atomicAdd(&(bar)[XB_TMO], 1u); break; } } } } while (0)
struct XcdBarrier { unsigned* bar; unsigned x; volatile LAS unsigned* st; };
__device__ __forceinline__ XcdBarrier xcd_barrier_post(unsigned* bar, volatile LAS unsigned* st) {
    XcdBarrier b; b.bar = bar; b.x = xb_xcc_id(); b.st = st;
    if (threadIdx.x == 0) (void)xb_add(&bar[XB_XCNT(b.x)], 1u);
    return b;
}
__device__ __forceinline__ void xcd_barrier_complete(unsigned* bar, unsigned x, unsigned& nloc, unsigned& nx) {
    const unsigned G = gridDim.x * gridDim.y * gridDim.z;
    unsigned sum, cnt, mine, sp = 0u;
    for (;;) {
        sum = 0u; cnt = 0u; mine = 0u;
#pragma unroll
        for (unsigned j = 0; j < 16; ++j) { const unsigned c = xb_ld(&bar[XB_XCNT(j)]); sum += c; cnt += (c > 0u) ? 1u : 0u; mine = (j == x) ? c : mine; }
        if (sum == G) break;
        __builtin_amdgcn_s_sleep(1);
        if ((++sp & 255u) == 0u) { if (xb_ld(&bar[XB_TMO])) break; if (sp > XB_SPIN_CAP) { atomicAdd(&bar[XB_TMO], 1u); break; } }
    }
    nloc = mine > 0u ? mine : 1u; nx = cnt > 0u ? cnt : 1u;
}
__device__ __forceinline__ void xcd_barrier(const XcdBarrier& b) {
    asm volatile("s_waitcnt vmcnt(0)" ::: "memory");
    __syncthreads();
    if (threadIdx.x == 0) {
        unsigned* bar = b.bar;
        __builtin_amdgcn_s_waitcnt(0);
        unsigned nloc = b.st[0], nx = b.st[1];
        if (nloc == 0u) { xcd_barrier_complete(bar, b.x, nloc, nx); b.st[0] = nloc; b.st[1] = nx; }
        const unsigned old = xb_add(&bar[XB_XSUB(b.x)], 1u);
        const unsigned gen = old / nloc;
        if (old + 1u == (gen + 1u) * nloc) {
            __builtin_amdgcn_fence(__ATOMIC_RELEASE, "agent");
            asm volatile("s_waitcnt vmcnt(0)" ::: "memory");
            const unsigned og = xb_add(&bar[XB_TOP], 1u);
            const unsigned tg = og / nx;
            if (og + 1u == (tg + 1u) * nx) xb_add(&bar[XB_TOPGEN], 1u);
            else XB_SPIN(xb_ld(&bar[XB_TOPGEN]) == tg, bar);
            __builtin_amdgcn_fence(__ATOMIC_ACQUIRE, "agent");
            xb_add(&bar[XB_XGEN(b.x)], 1u);
            asm volatile("s_waitcnt vmcnt(0)" ::: "memory");
        } else {
            XB_SPIN(xb_ld(&bar[XB_XGEN(b.x)]) == gen, bar);
            __builtin_amdgcn_fence(__ATOMIC_ACQUIRE, "agent");
            asm volatile("s_waitcnt vmcnt(0)" ::: "memory");
        }
    }
    __syncthreads();
}

DEVINL void* ldp(volatile LAS unsigned* A, int i) {
    const unsigned lo = __builtin_amdgcn_readfirstlane(A[2 * i]), hi = __builtin_amdgcn_readfirstlane(A[2 * i + 1]);
    return (void*)(((u64)hi << 32) | lo);
}
DEVINL void build_frame(Frame& F, volatile LAS unsigned* A) {
    { int t_ = threadIdx.x; asm volatile("" : "+v"(t_)); F.tid = t_; } F.lane = F.tid & 63; F.wave = __builtin_amdgcn_readfirstlane(F.tid >> 6); F.G = gridDim.x; F.bid = blockIdx.x;
    F.x = (const float*)ldp(A, 0); F.c = (const float*)ldp(A, 1); F.pos = (const int*)ldp(A, 2); F.w_ada = (const float*)ldp(A, 3); F.b_ada = (const float*)ldp(A, 4);
    F.w_in = (const float*)ldp(A, 5); F.ikg = (const float*)ldp(A, 6); F.ikb = (const float*)ldp(A, 7); F.qng = (const float*)ldp(A, 8); F.w_q_up = (const float*)ldp(A, 9);
    F.kvng = (const float*)ldp(A, 10); F.w_kv_up = (const float*)ldp(A, 11); F.onag = (const float*)ldp(A, 12); F.onbg = (const float*)ldp(A, 13); F.w_out = (const float*)ldp(A, 14);
    F.lnmg = (const float*)ldp(A, 15); F.lnmb = (const float*)ldp(A, 16); F.w_router = (const float*)ldp(A, 17); F.b_router = (const float*)ldp(A, 18);
    F.w_gu = (const float*)ldp(A, 19); F.b_gu = (const float*)ldp(A, 20); F.w_dn = (const float*)ldp(A, 21); F.b_dn = (const float*)ldp(A, 22); F.lnfg = (const float*)ldp(A, 23); F.lnfb = (const float*)ldp(A, 24);
    F.out = (float*)ldp(A, 25);
    unsigned char* ws = (unsigned char*)ldp(A, 26);
    F.ctl = (unsigned*)(ws + WS_CTL); F.ada = (float*)(ws + WS_ADA); F.list = (int*)(ws + WS_LIST); F.tope = (int*)(ws + WS_TOPE); F.gate = (float*)(ws + WS_GATE); F.mask = (u64*)(ws + WS_MASK);
    F.h = (float*)(ws + WS_H); F.proj = (float*)(ws + WS_PROJ); F.qb = (float*)(ws + WS_QB); F.kv = (float*)(ws + WS_KV); F.oab = (float*)(ws + WS_OAB); F.x1 = (float*)(ws + WS_X1);
    F.act = (float*)(ws + WS_ACT); F.y = (float*)(ws + WS_Y);
    F.WinT = (f16*)(ws + WS_WINT); F.hA = (f16*)(ws + WS_HA); F.projh = (f16*)(ws + WS_PROJH); F.tab = (float*)(ws + WS_TAB); F.ssq = (float*)(ws + WS_SSQ); F.sskv = (float*)(ws + WS_SSKV);
    F.WoutT = (f16*)(ws + WS_WOUTT); F.WguT = (f16*)(ws + WS_WGUT); F.WdT = (f16*)(ws + WS_WDT); F.bguP = (float*)(ws + WS_BGUP); F.mrgh = (f16*)(ws + WS_MRGH); F.act16 = (f16*)(ws + WS_ACT16); F.y16 = (f16*)(ws + WS_Y16);
    F.WqupT = (f16*)(ws + WS_WQUPT); F.WkvupT = (f16*)(ws + WS_WKVUPT); F.qb16 = (f16*)(ws + WS_QB16); F.kv16 = (f16*)(ws + WS_KV16); F.att16 = (f16*)(ws + WS_ATT16); F.WrT = (f16*)(ws + WS_WRT); F.ikv = (float*)(ws + WS_IKV); F.score = (float*)(ws + WS_SCORE); F.rq = (float*)(ws + WS_RQ); F.rkv = (float*)(ws + WS_RKV);
}
template <int PLO, int PHI> __global__ void __launch_bounds__(NTHREADS, 2) fwd(Args args) {
    extern __shared__ __attribute__((aligned(16))) unsigned char lds_raw[];
    float* lds = (float*)lds_raw;
    volatile LAS unsigned* argl = (volatile LAS unsigned*)((LAS unsigned char*)lds_raw + (LDS_BYTES - 512));
    if (threadIdx.x < 54) argl[threadIdx.x] = ((const unsigned*)&args)[threadIdx.x];
    __syncthreads();
    Frame F; build_frame(F, argl);
#define IN(k) (PLO <= (k) && (k) < PHI)
    volatile LAS unsigned* xbst = (volatile LAS unsigned*)((LAS unsigned char*)lds_raw + (LDS_BYTES - 16));
    XcdBarrier bar; bar.bar = F.ctl + CW_BAR; bar.x = 0; bar.st = xbst;
    if constexpr (PHI - PLO > 1) {
        if (F.tid == 0) { xbst[0] = 0u; xbst[1] = 0u; xbst[2] = 0u; xbst[3] = 0u; }
        __syncthreads();
        bar = xcd_barrier_post(F.ctl + CW_BAR, xbst);
    }
#define SEAM(k) do { if constexpr (IN(k) && IN((k) + 1)) xcd_barrier(bar); } while (0)

    if constexpr (IN(0)) for (int rep_ = 0; rep_ < REPS(0); ++rep_) p_ada(F, lds);
    if constexpr (IN(0) && IN(1)) {
        asm volatile("s_waitcnt vmcnt(0)" ::: "memory"); __syncthreads();
        if (threadIdx.x == 0) { __builtin_amdgcn_fence(__ATOMIC_RELEASE, "agent"); (void)xb_add(F.ctl + CW_ADA, 1u); }
    }
    build_frame(F, argl);
    if constexpr (IN(1)) for (int rep_ = 0; rep_ < REPS(1); ++rep_) {
        const int nconv = (F.G >= 2 * CONV_C && ((F.G - CONV_C) & 7) == 0) ? CONV_C : 0, G2 = F.G - nconv;
        if (F.bid >= G2) p_moeconv(F, lds, (F.bid - G2) * NWAVES + F.wave, nconv * NWAVES, 0, HEAD_STEPS);
        else p_prologue(F, lds, F.bid * NWAVES + F.wave, G2 * NWAVES);
    }
    SEAM(1); build_frame(F, argl);
    if constexpr (IN(2)) for (int rep_ = 0; rep_ < REPS(2); ++rep_) {
        const int nconv = (F.G >= 2 * CONV_C && ((F.G - CONV_C) & 7) == 0) ? CONV_C : 0, G2 = F.G - nconv;
        if (F.bid >= G2) p_moeconv(F, lds, (F.bid - G2) * NWAVES + F.wave, nconv * NWAVES, HEAD_STEPS);
        else {
            if (nconv == 0) { p_moeconv(F, lds, F.bid * NWAVES + F.wave, F.G * NWAVES); __syncthreads(); build_frame(F, argl); }
            g16::Gemm g{F.hA, F.WinT, D, D, D}; g16::StaticOrder So; So.init(NT, NV, G2, F.bid, P2_WGM);
            EpiInProj E{F.projh, F.tab, F.ssq, F.sskv, F.ikv};
            g16::gemm_phase<EpiInProj, g16::StaticOrder>((LAS unsigned char*)lds_raw, g, So, E);
        }
    }
    SEAM(2); build_frame(F, argl);
#if EXTRA_BARRIERS
    for (int xb_ = 0; xb_ < EXTRA_BARRIERS; ++xb_) xcd_barrier(bar);
#endif
#if DUMMY_GEMM
    {
        g16::Gemm g{F.hA, F.WinT, D, D, D}; g16::StaticOrder So; So.init(NT, NV, F.G, F.bid);
        EpiPlain E{F.act16};
        g16::gemm_phase<EpiPlain, g16::StaticOrder>((LAS unsigned char*)lds_raw, g, So, E);
        __syncthreads(); build_frame(F, argl);
    }
#endif
    if constexpr (IN(4)) for (int rep_ = 0; rep_ < REPS(4); ++rep_) {
        { g16::Gemm g{F.projh + V_QD, F.WqupT, NV, 512, 512}; g16::StaticOrder So; So.init(NT, 1536, F.G, F.bid); EpiQup E{F.qb16, F.tab, F.ssq};
          g16::gemm_phase<EpiQup, g16::StaticOrder>((LAS unsigned char*)lds_raw, g, So, E); }
    }
    __syncthreads(); build_frame(F, argl);
    if constexpr (IN(5)) for (int rep_ = 0; rep_ < REPS(5); ++rep_) {
        g16::Gemm g{F.projh + V_KVD, F.WkvupT, NV, 256, 256}; g16::StaticOrder So; So.init(NT, D, F.G, F.bid); EpiKVup E{F.kv16, F.sskv};
        g16::gemm_phase<EpiKVup, g16::StaticOrder>((LAS unsigned char*)lds_raw, g, So, E);
    }
    __syncthreads(); build_frame(F, argl);
    if constexpr (IN(6)) for (int rep_ = 0; rep_ < REPS(6); ++rep_) p_index16(F, (LAS unsigned char*)lds_raw, rep_ * PROBE_IDX);
    SEAM(6); build_frame(F, argl);
    if constexpr (IN(7)) for (int rep_ = 0; rep_ < REPS(7); ++rep_) p_topk16(F, (LAS unsigned char*)lds_raw);
    SEAM(7); build_frame(F, argl);
    if constexpr (IN(8)) for (int rep_ = 0; rep_ < REPS(8); ++rep_) p_attn16(F, (LAS unsigned char*)lds_raw, rep_ * PROBE_ATT);
    SEAM(8); build_frame(F, argl);
    if constexpr (IN(9)) for (int rep_ = 0; rep_ < REPS(9); ++rep_) p_merge16(F);
    SEAM(9); build_frame(F, argl);
    if constexpr (IN(10)) for (int rep_ = 0; rep_ < REPS(10); ++rep_) {
#if OUTPROJ_F8
        g16::Gemm g{F.mrgh, F.WoutT, D / 2, D / 2, D / 2, 1}; g16::StaticOrder So; So.init(NT, D, F.G, F.bid);
        EpiPre16 E{(f16*)F.x1, F.x, F.ada, W8_INV};
        g16::gemm_phase<EpiPre16, g16::StaticOrder, true, true>((LAS unsigned char*)lds_raw, g, So, E);
#else
        g16::Gemm g{F.mrgh, F.WoutT, D, D, D}; g16::StaticOrder So; So.init(NT, D, F.G, F.bid);
        EpiPre16 E{(f16*)F.x1, F.x, F.ada, 1.f};
        g16::gemm_phase<EpiPre16, g16::StaticOrder>((LAS unsigned char*)lds_raw, g, So, E);
#endif
    }
    SEAM(10); build_frame(F, argl);
    if constexpr (IN(11)) for (int rep_ = 0; rep_ < REPS(11); ++rep_) p_router16(F, (LAS unsigned char*)lds_raw);
    SEAM(11); build_frame(F, argl);
#if MOE_FAST
    if constexpr (IN(12)) for (int rep_ = 0; rep_ < REPS(12); ++rep_) {
        LAS MoeLds* T = (LAS MoeLds*)((LAS unsigned char*)lds_raw + 131072 + 1024);
        moe_lds_build(F, T);
        g16::Gemm g{F.hA, F.WguT, D / 2, D / 2, D / 2, 1}; MoeOrder<2> So{T, F.list, F.bid & 7, F.bid >> 3, F.G >> 3};
        EpiGU8 E{(unsigned char*)F.act16, F.bguP, rep_ * PROBE_IDX};
        g16::gemm_phase<EpiGU8, MoeOrder<2>, true, true>((LAS unsigned char*)lds_raw, g, So, E);
    }
    SEAM(12); build_frame(F, argl);
    if constexpr (IN(13)) for (int rep_ = 0; rep_ < REPS(13); ++rep_) {
        LAS MoeLds* T = (LAS MoeLds*)((LAS unsigned char*)lds_raw + 131072 + 1024);
        moe_lds_build(F, T);
        g16::Gemm g{F.act16, F.WdT, DFF / 2, DFF / 2, DFF / 2, 1}; MoeOrder<1> So{T, F.list, F.bid & 7, F.bid >> 3, F.G >> 3};
        EpiDown16 E{F.y16, F.b_dn, F.list, F.gate, T, W8_INV};
        g16::gemm_phase<EpiDown16, MoeOrder<1>, true, true>((LAS unsigned char*)lds_raw, g, So, E);
    }
    SEAM(13); build_frame(F, argl);
    if constexpr (IN(14)) for (int rep_ = 0; rep_ < REPS(14); ++rep_) p_final16(F);
#else
    if constexpr (IN(12)) for (int rep_ = 0; rep_ < REPS(12); ++rep_) {
        MoeTab* tb = (MoeTab*)(lds + 32 * 129 + 32 * 256);
        moe_tab(F, tb);
        const int ntile = tb->tstart[NE];
        for (int u = F.bid; u < ntile * 16; u += F.G) {
            const int rt = u >> 4, ct = u & 15; int e = 0;
            while (e < NE - 1 && rt >= tb->tstart[e + 1]) ++e;
            const int r0 = (rt - tb->tstart[e]) * 128, cnt = tb->cnt[e];
            RowGatherH rp{F.h, F.list + (size_t)e * LISTCAP, r0, cnt};
            EpiGU ep{F.act, F.b_gu + (size_t)e * 2 * DFF, tb->offs[e], r0, cnt, F.lane};
            gemm_tile_f32(lds, rp, F.w_gu + (size_t)e * D * 2 * DFF, 2 * DFF, D, ct * 256, 2 * DFF, ep);
        }
    }
    SEAM(12); build_frame(F, argl);
    if constexpr (IN(13)) for (int rep_ = 0; rep_ < REPS(13); ++rep_) {
        MoeTab* tb = (MoeTab*)(lds + 32 * 129 + 32 * 256);
        moe_tab(F, tb);
        const int ntile = tb->tstart[NE];
        for (int u = F.bid; u < ntile * 8; u += F.G) {
            const int rt = u >> 3, ct = u & 7; int e = 0;
            while (e < NE - 1 && rt >= tb->tstart[e + 1]) ++e;
            const int r0 = (rt - tb->tstart[e]) * 128, cnt = tb->cnt[e];
            RowAct rp{F.act, tb->offs[e], r0, cnt};
            EpiDown ep{F.y, F.b_dn + (size_t)e * D, F.list + (size_t)e * LISTCAP, F.gate, r0, cnt};
            gemm_tile_f32(lds, rp, F.w_dn + (size_t)e * DFF * D, D, DFF, ct * 256, D, ep);
        }
    }
    SEAM(13); build_frame(F, argl);
    if constexpr (IN(14)) for (int rep_ = 0; rep_ < REPS(14); ++rep_) p_final(F);
#endif
#undef IN
}

constexpr int NPHASE = 15;
template <int P> static void launch_one(int grid, hipStream_t stream, const Args& a) {
    static bool attr = false;
    if (!attr) { (void)hipFuncSetAttribute((const void*)fwd<P, P + 1>, hipFuncAttributeMaxDynamicSharedMemorySize, LDS_BYTES); attr = true; }
    hipLaunchKernelGGL((fwd<P, P + 1>), dim3(grid), dim3(NTHREADS), LDS_BYTES, stream, a);
}
template <int P> static void launch_all(int grid, hipStream_t stream, const Args& a) {
    if constexpr (P < NPHASE) {
        launch_one<P>(grid, stream, a);
        launch_all<P + 1>(grid, stream, a);
    }
}
extern "C" void kernel_launch(void* const* d_in, const int* in_sizes, int n_in, void* d_out, int out_size, void* d_ws, size_t ws_size, hipStream_t stream) {
    static int grid = 0;
    if (grid == 0) {
        if (n_in != 25 || out_size != NT * D || ws_size < WS_END4) { fprintf(stderr, "kernel_launch: unexpected shapes (n_in %d out %d ws %zu)\n", n_in, out_size, ws_size); grid = -1; return; }
        int dev = 0, cus = 0;
        if (hipGetDevice(&dev) != hipSuccess || hipDeviceGetAttribute(&cus, hipDeviceAttributeMultiprocessorCount, dev) != hipSuccess) { grid = -1; return; }
        grid = cus;
    }
    if (grid < 0) return;
    (void)hipMemsetAsync((char*)d_ws + WS_CTL, 0, CTL_ZERO_BYTES, stream);
    Args a{};
    for (int i = 0; i < 25; ++i) a.in[i] = d_in[i];
    a.out = (float*)d_out; a.ws = (unsigned char*)d_ws;
#if MULTI_LAUNCH
    launch_all<0>(grid, stream, a);
#else
    static bool attr = false;
    if (!attr) { (void)hipFuncSetAttribute((const void*)fwd<0, NPHASE>, hipFuncAttributeMaxDynamicSharedMemorySize, LDS_BYTES); attr = true; }
    hipLaunchKernelGGL((fwd<0, NPHASE>), dim3(grid), dim3(NTHREADS), LDS_BYTES, stream, a);
#endif
}
```
